# Optimizing an MI355X kernel written in HIP

```python
import jax, jax.numpy as jnp
from jax import lax
import numpy as np

D_MODEL = 2048
BATCH = 1
SEQ = 8192
DEPTH = 2

CHUNK = 64
Q_BLOCK = 2 * CHUNK
HEAD_DIM = 128
MIX_HEADS = 12
MEM_HEADS = 4
MIX_W = MIX_HEADS * HEAD_DIM
MEM_W = MEM_HEADS * HEAD_DIM
N_MEM = 256
N_MIXERS = 2
N_EXPERTS = 64
TOP_K = 8
N_GROUPS = 8
TOPK_GROUPS = 4
GROUP_TOP = 2
EXPERT_FF = 512
ROUTED_SCALE = 2.5
ALPHA = float((2 * DEPTH) ** 0.25)
BETA = float((8 * DEPTH) ** -0.25)
LN_EPS = 1e-5

kernel_name = "hybrid_stickbreak_fox_moe_deepnorm"


def _layer_norm(x, g, b):
    xf = x.astype(jnp.float32)
    mu = jnp.mean(xf, axis=-1, keepdims=True)
    var = jnp.mean(jnp.square(xf - mu), axis=-1, keepdims=True)
    y = (xf - mu) * lax.rsqrt(var + LN_EPS) * g.astype(jnp.float32) + b.astype(jnp.float32)
    return y.astype(x.dtype)


def _split_heads(t, n_heads):
    B, S, _ = t.shape
    return t.reshape(B, S, n_heads, HEAD_DIM).transpose(0, 2, 1, 3)


def _stick_breaking_attention(q, k, v):
    B, H, S, dh = q.shape
    qf = q.astype(jnp.float32) * (dh ** -0.5)
    kf = k.astype(jnp.float32)
    key_pos = jnp.arange(S)

    def block(b):
        start = b * Q_BLOCK
        qb = lax.dynamic_slice_in_dim(qf, start, Q_BLOCK, axis=2)
        z = jnp.einsum('bhqd,bhkd->bhqk', qb, kf)
        q_pos = start + jnp.arange(Q_BLOCK)
        strict = key_pos[None, :] < q_pos[:, None]
        log_stay = jnp.where(strict, jax.nn.log_sigmoid(-z), 0.0)
        log_after = lax.cumsum(log_stay, axis=3, reverse=True) - log_stay
        w = jnp.where(strict, jnp.exp(jax.nn.log_sigmoid(z) + log_after), 0.0)
        return jnp.einsum('bhqk,bhkd->bhqd', w.astype(v.dtype), v)

    out = lax.map(block, jnp.arange(S // Q_BLOCK))
    return out.transpose(1, 2, 0, 3, 4).reshape(B, H, S, dh)


def _forgetting_attention(q, k, v, log_f):
    B, H, S, dh = q.shape
    qf = q.astype(jnp.float32) * (dh ** -0.5)
    kf = k.astype(jnp.float32)
    cum_f = lax.cumsum(log_f, axis=2)
    key_pos = jnp.arange(S)

    def block(b):
        start = b * Q_BLOCK
        qb = lax.dynamic_slice_in_dim(qf, start, Q_BLOCK, axis=2)
        fq = lax.dynamic_slice_in_dim(cum_f, start, Q_BLOCK, axis=2)
        logits = jnp.einsum('bhqd,bhkd->bhqk', qb, kf) + fq[..., :, None] - cum_f[..., None, :]
        q_pos = start + jnp.arange(Q_BLOCK)
        causal = key_pos[None, :] <= q_pos[:, None]
        p = jax.nn.softmax(jnp.where(causal, logits, -jnp.inf), axis=-1)
        return jnp.einsum('bhqk,bhkd->bhqd', p.astype(v.dtype), v)

    out = lax.map(block, jnp.arange(S // Q_BLOCK))
    return out.transpose(1, 2, 0, 3, 4).reshape(B, H, S, dh)


def _memory_attention(q, k_mem, v_mem):
    s = jnp.einsum('bhqd,bhmd->bhqm', q.astype(jnp.float32), k_mem.astype(jnp.float32)) * (HEAD_DIM ** -0.5)
    p = jax.nn.softmax(s, axis=-1)
    return jnp.einsum('bhqm,bhmd->bhqd', p.astype(v_mem.dtype), v_mem)


def _attention_sublayer(x, w_in, forget_bias, w_o, k_mem, v_mem, mixer):
    B, S, _ = x.shape
    proj = x @ w_in
    q = _split_heads(proj[..., :MIX_W], MIX_HEADS)
    k = _split_heads(proj[..., MIX_W:2 * MIX_W], MIX_HEADS)
    v = _split_heads(proj[..., 2 * MIX_W:3 * MIX_W], MIX_HEADS)
    q_mem = _split_heads(proj[..., 3 * MIX_W:3 * MIX_W + MEM_W], MEM_HEADS)
    if mixer == 0:
        o_mix = _stick_breaking_attention(q, k, v)
    else:
        f_logit = proj[..., 3 * MIX_W + MEM_W:].astype(jnp.float32) + forget_bias.astype(jnp.float32)
        log_f = jax.nn.log_sigmoid(f_logit).transpose(0, 2, 1)
        o_mix = _forgetting_attention(q, k, v, log_f)
    o_mem = _memory_attention(q_mem, k_mem, v_mem)
    o = jnp.concatenate([o_mix, o_mem], axis=1)
    o = o.transpose(0, 2, 1, 3).reshape(B, S, MIX_W + MEM_W)
    return o @ w_o


def _moe(x, w_router, router_bias, exp_w_gu, exp_w_down, shared_w_gu, shared_w_down):
    B, S, D = x.shape
    xt = x.reshape(B * S, D)
    T = xt.shape[0]
    scores = jax.nn.sigmoid((xt @ w_router).astype(jnp.float32))
    sel = scores + router_bias.astype(jnp.float32)
    grouped = sel.reshape(T, N_GROUPS, N_EXPERTS // N_GROUPS)
    group_score = jnp.sum(lax.top_k(grouped, GROUP_TOP)[0], axis=-1)
    _, g_idx = lax.top_k(group_score, TOPK_GROUPS)
    group_mask = jnp.sum(jax.nn.one_hot(g_idx, N_GROUPS, dtype=jnp.float32), axis=1)
    expert_mask = jnp.repeat(group_mask, N_EXPERTS // N_GROUPS, axis=1) > 0
    _, e_idx = lax.top_k(jnp.where(expert_mask, sel, -jnp.inf), TOP_K)
    w = jnp.take_along_axis(scores, e_idx, axis=1)
    w = w / jnp.sum(w, axis=-1, keepdims=True) * ROUTED_SCALE
    gates = jnp.einsum('tke,tk->te', jax.nn.one_hot(e_idx, N_EXPERTS, dtype=jnp.float32), w).astype(x.dtype)

    def expert(acc, p):
        w_gu, w_down, g = p
        a, u = jnp.split(xt @ w_gu, 2, axis=-1)
        y = (jax.nn.silu(a) * u) @ w_down
        return acc + (g[:, None] * y).astype(acc.dtype), None

    routed, _ = lax.scan(expert, jnp.zeros_like(xt), (exp_w_gu, exp_w_down, gates.T))
    a, u = jnp.split(xt @ shared_w_gu, 2, axis=-1)
    shared = (jax.nn.silu(a) * u) @ shared_w_down
    return (routed + shared).reshape(B, S, D)


def _normal(k, shape, scale):
    return jax.random.normal(k, shape, jnp.float32) * scale


def _layer_params(key, mixer):
    ks = jax.random.split(key, 16)
    s_in = D_MODEL ** -0.5
    parts = [_normal(ks[0], (D_MODEL, MIX_W), s_in),
             _normal(ks[1], (D_MODEL, MIX_W), s_in),
             _normal(ks[2], (D_MODEL, MIX_W), s_in * BETA),
             _normal(ks[3], (D_MODEL, MEM_W), s_in)]
    if mixer == 1:
        parts.append(_normal(ks[4], (D_MODEL, MIX_HEADS), 0.5 * s_in))
    p = {'w_in': jnp.concatenate(parts, axis=1)}
    if mixer == 1:
        p['forget_bias'] = jax.random.uniform(ks[5], (MIX_HEADS,), jnp.float32, 1.0, 4.0)
    p['w_o'] = _normal(ks[6], (MIX_W + MEM_W, D_MODEL), (MIX_W + MEM_W) ** -0.5 * BETA)
    p['ln_attn_g'] = 1.0 + _normal(ks[7], (D_MODEL,), 0.02)
    p['ln_attn_b'] = _normal(ks[8], (D_MODEL,), 0.02)
    p['router'] = _normal(ks[9], (D_MODEL, N_EXPERTS), s_in)
    p['router_bias'] = _normal(ks[10], (N_EXPERTS,), 0.01)
    p['exp_w_gu'] = _normal(ks[11], (N_EXPERTS, D_MODEL, 2 * EXPERT_FF), s_in)
    p['exp_w_down'] = _normal(ks[12], (N_EXPERTS, EXPERT_FF, D_MODEL), EXPERT_FF ** -0.5 * BETA)
    p['shared_w_gu'] = _normal(ks[13], (D_MODEL, 2 * EXPERT_FF), s_in)
    p['shared_w_down'] = _normal(ks[14], (EXPERT_FF, D_MODEL), EXPERT_FF ** -0.5 * BETA)
    kg, kb = jax.random.split(ks[15])
    p['ln_ffn_g'] = 1.0 + _normal(kg, (D_MODEL,), 0.02)
    p['ln_ffn_b'] = _normal(kb, (D_MODEL,), 0.02)
    return p


def setup_inputs(seed: int = 0) -> dict:
    key = jax.random.key(seed)
    ks = jax.random.split(key, 5 + DEPTH)
    s_in = D_MODEL ** -0.5
    inputs = {
        'x': _normal(ks[0], (BATCH, SEQ, D_MODEL), 1.0),
        'mem': _normal(ks[1], (BATCH, N_MEM, D_MODEL), 1.0),
        'mem_ln_g': 1.0 + _normal(ks[2], (D_MODEL,), 0.02),
        'mem_ln_b': _normal(ks[3], (D_MODEL,), 0.02),
        'w_mem_kv': jnp.concatenate([_normal(jax.random.fold_in(ks[4], 0), (D_MODEL, MEM_W), s_in),
                                     _normal(jax.random.fold_in(ks[4], 1), (D_MODEL, MEM_W), s_in * BETA)], axis=1),
    }
    for i in range(DEPTH):
        for name, arr in _layer_params(ks[5 + i], i % N_MIXERS).items():
            inputs['l%d_%s' % (i, name)] = arr
    return inputs


def reference(x, mem, mem_ln_g, mem_ln_b, w_mem_kv,
              l0_w_in, l0_w_o, l0_ln_attn_g, l0_ln_attn_b, l0_router, l0_router_bias,
              l0_exp_w_gu, l0_exp_w_down, l0_shared_w_gu, l0_shared_w_down, l0_ln_ffn_g, l0_ln_ffn_b,
              l1_w_in, l1_forget_bias, l1_w_o, l1_ln_attn_g, l1_ln_attn_b, l1_router, l1_router_bias,
              l1_exp_w_gu, l1_exp_w_down, l1_shared_w_gu, l1_shared_w_down, l1_ln_ffn_g, l1_ln_ffn_b):
    kv = _layer_norm(mem, mem_ln_g, mem_ln_b) @ w_mem_kv
    k_mem = _split_heads(kv[..., :MEM_W], MEM_HEADS)
    v_mem = _split_heads(kv[..., MEM_W:], MEM_HEADS)

    layers = [
        (l0_w_in, None, l0_w_o, l0_ln_attn_g, l0_ln_attn_b, l0_router, l0_router_bias,
         l0_exp_w_gu, l0_exp_w_down, l0_shared_w_gu, l0_shared_w_down, l0_ln_ffn_g, l0_ln_ffn_b),
        (l1_w_in, l1_forget_bias, l1_w_o, l1_ln_attn_g, l1_ln_attn_b, l1_router, l1_router_bias,
         l1_exp_w_gu, l1_exp_w_down, l1_shared_w_gu, l1_shared_w_down, l1_ln_ffn_g, l1_ln_ffn_b),
    ]
    for i in range(DEPTH):
        (w_in, forget_bias, w_o, ln_attn_g, ln_attn_b, router, router_bias,
         exp_w_gu, exp_w_down, shared_w_gu, shared_w_down, ln_ffn_g, ln_ffn_b) = layers[i]
        mix = _attention_sublayer(x, w_in, forget_bias, w_o, k_mem, v_mem, i % N_MIXERS)
        x = _layer_norm(ALPHA * x + mix, ln_attn_g, ln_attn_b)
        ffn = _moe(x, router, router_bias, exp_w_gu, exp_w_down, shared_w_gu, shared_w_down)
        x = _layer_norm(ALPHA * x + ffn, ln_ffn_g, ln_ffn_b)
    return x
```

```cpp
#include <hip/hip_runtime.h>
#include <cstdio>
#include <cstdint>

#define LAS __attribute__((address_space(3)))
#define GAS __attribute__((address_space(1)))
typedef unsigned short bf16_t;
typedef short bf16x8 __attribute__((ext_vector_type(8)));
typedef short s16x4 __attribute__((ext_vector_type(4)));
typedef float f32x2 __attribute__((ext_vector_type(2)));
typedef float f32x4 __attribute__((ext_vector_type(4)));
typedef float f32x16 __attribute__((ext_vector_type(16)));
typedef unsigned u32x2 __attribute__((ext_vector_type(2)));
typedef unsigned u32x4 __attribute__((ext_vector_type(4)));

constexpr int S_ = 8192, D_ = 2048, HD = 128, NH = 12, NMH = 4, NMEM = 256, NE = 64, TOPK = 8, EFF = 512;
constexpr int NQKV0 = 5120, NQKV1 = 5132, NQKV1P = 5376;
constexpr float ALPHA = 1.4142135623730951f, LN_EPS = 1e-5f, LOG2E = 1.4426950408889634f, LN2 = 0.6931471805599453f;
constexpr float QSCALE = 0.08838834764831845f * 1.4426950408889634f;
constexpr int MAXTILES = 352, MAXROWS = MAXTILES * 256;

constexpr size_t MiB = 1u << 20;
constexpr size_t WS_CTL = 0, CTL_ZERO_BYTES = 1 * MiB;
constexpr size_t WS_WIN0 = 1 * MiB, WS_WIN1 = 21 * MiB, WS_WO0 = 42 * MiB, WS_WO1 = 50 * MiB, WS_WMEM = 58 * MiB;
constexpr size_t WS_WGU0 = 62 * MiB, WS_WGU1 = 322 * MiB, WS_WD0 = 582 * MiB, WS_WD1 = 712 * MiB;
constexpr size_t WS_XB = 842 * MiB, WS_X2F = 874 * MiB, WS_QKV = 938 * MiB, WS_FLOG = 1018 * MiB, WS_KVMEM = 1019 * MiB, WS_MEMN = 1020 * MiB;
constexpr size_t WS_AO = 1021 * MiB, WS_T1 = 1053 * MiB, WS_X1F = 1117 * MiB, WS_X1B = 1181 * MiB;
constexpr size_t WS_TKE = 1213 * MiB, WS_TKW = WS_TKE + 256 * 1024, WS_TKP = WS_TKE + 512 * 1024, WS_LIST = 1214 * MiB, WS_ROWW = 1216 * MiB;
constexpr size_t WS_H = 1218 * MiB, WS_Y = 1306 * MiB, WS_CFN = 1658 * MiB, WS_END = 1659 * MiB;
constexpr int CW_BAR = 4096, CW_CNT = 16384;

__device__ __forceinline__ unsigned cvtpk(float lo, float hi) { unsigned r; asm volatile("v_cvt_pk_bf16_f32 %0, %1, %2" : "=v"(r) : "v"(lo), "v"(hi)); return r; }
__device__ __forceinline__ float bf2f(bf16_t b) { return __uint_as_float(((unsigned)b) << 16); }
__device__ __forceinline__ bf16_t f2bf(float f) { return (bf16_t)(cvtpk(f, 0.f) & 0xffffu); }
__device__ __forceinline__ int crow(int r, int hi) { return (r & 3) + 8 * (r >> 2) + 4 * hi; }
__device__ __forceinline__ float wave_sum(float v) {
#pragma unroll
    for (int o = 1; o < 64; o <<= 1) v += __shfl_xor(v, o);
    return v;
}
__device__ __forceinline__ float wave_max(float v) {
#pragma unroll
    for (int o = 1; o < 64; o <<= 1) v = fmaxf(v, __shfl_xor(v, o));
    return v;
}
__device__ __forceinline__ float softplusf(float z) { return fmaxf(z, 0.f) + log1pf(expf(-fabsf(z))); }

__device__ __forceinline__ int opaque_tid() { int t = (int)threadIdx.x; asm volatile("" : "+v"(t)); return t; }
struct Args { const float* in[30]; float* out; unsigned char* ws; int ph_lo, ph_hi; };

__device__ __forceinline__ void slow_prefix(const unsigned* gcnt, int* cntl, int* tp) {
    if (threadIdx.x < 64) cntl[threadIdx.x] = (int)gcnt[threadIdx.x];
    if (threadIdx.x == 64) cntl[64] = S_;
    __syncthreads();
    if (threadIdx.x == 0) { int a = 0; for (int e = 0; e < 65; ++e) { tp[e] = a; a += (cntl[e] + 255) >> 8; } tp[65] = a; }
    __syncthreads();
}
struct SlowP { const bf16_t* A; const float* W; int K, ldw, N, M; int L, pad; unsigned char* ws; const float* xf; const float* W2; };
template <int MODE> __global__ __launch_bounds__(256) void slow_gemm(SlowP p) {
    __shared__ int cntl[65]; __shared__ int tp[66];
    const int wave = threadIdx.x >> 6, lane = threadIdx.x & 63, r = lane & 31, hi = lane >> 5, wm = wave >> 1, wn = wave & 1;
    const int n0 = blockIdx.x * 64 + wn * 32; int m0 = blockIdx.y * 64 + wm * 32;
    const bf16_t* arow; const float* W = p.W; int e = 0, cnt = 0, lbase = 0;
    if (MODE >= 3) {
        slow_prefix((const unsigned*)(p.ws + WS_CTL) + CW_CNT + 64 * p.L, cntl, tp);
        const int tile = (blockIdx.y * 64) >> 8; if (tile >= tp[65]) return;
        while (tp[e + 1] <= tile) ++e;
        cnt = cntl[e]; lbase = (tile - tp[e]) * 256 + ((blockIdx.y * 64) & 255) + wm * 32;
        if (MODE == 3) { const int lr = lbase + r; int tok = 0; if (lr < cnt) tok = (e < 64) ? ((const int*)(p.ws + WS_LIST))[e * S_ + lr] : lr; arow = p.A + (size_t)tok * p.K;
            W = (e < 64) ? p.W + (size_t)e * D_ * 1024 : p.W2; }
        else { arow = p.A + (size_t)(m0 + r) * p.K; W = (e < 64) ? p.W + (size_t)e * EFF * D_ : p.W2; }
    } else arow = p.A + (size_t)(m0 + r) * p.K;
    const int col = n0 + r; const bool cok = col < p.N;
    f32x16 acc = {}, acc2 = {};
    for (int k0 = 0; k0 < p.K; k0 += 16) {
        const bf16x8 a = *(const bf16x8*)(arow + k0 + 8 * hi);
        float bv[8], bu[8];
#pragma unroll
        for (int j = 0; j < 8; ++j) { bv[j] = cok ? W[(size_t)(k0 + 8 * hi + j) * p.ldw + col] : 0.f; if (MODE == 3) bu[j] = W[(size_t)(k0 + 8 * hi + j) * p.ldw + col + EFF]; }
        u32x4 bw = {cvtpk(bv[0], bv[1]), cvtpk(bv[2], bv[3]), cvtpk(bv[4], bv[5]), cvtpk(bv[6], bv[7])};
        acc = __builtin_amdgcn_mfma_f32_32x32x16_bf16(a, *(bf16x8*)&bw, acc, 0, 0, 0);
        if (MODE == 3) { u32x4 bw2 = {cvtpk(bu[0], bu[1]), cvtpk(bu[2], bu[3]), cvtpk(bu[4], bu[5]), cvtpk(bu[6], bu[7])};
            acc2 = __builtin_amdgcn_mfma_f32_32x32x16_bf16(a, *(bf16x8*)&bw2, acc2, 0, 0, 0); }
    }
    if (!cok) return;
#pragma unroll
    for (int g = 0; g < 16; ++g) {
        const int row = m0 + crow(g, hi); const float v = acc[g];
        if (MODE == 0) {
            if (col < 5120) { const int head = col >> 7; const float sc = (head < 12 || head >= 36) ? QSCALE : 1.f;
                ((bf16_t*)(p.ws + WS_QKV))[((size_t)head * S_ + row) * HD + (col & 127)] = f2bf(v * sc); }
            else ((float*)(p.ws + WS_FLOG))[(size_t)(col - 5120) * S_ + row] = v;
        } else if (MODE == 1) {
            ((float*)(p.ws + WS_T1))[(size_t)row * D_ + col] = ALPHA * p.xf[(size_t)row * D_ + col] + v;
        } else if (MODE == 2) {
            ((bf16_t*)(p.ws + WS_KVMEM))[((size_t)(col >> 7) * NMEM + row) * HD + (col & 127)] = f2bf(v);
        } else if (MODE == 3) {
            const float u = acc2[g]; const float hv = v / (1.f + expf(-v)) * u;
            ((bf16_t*)(p.ws + WS_H))[(size_t)row * EFF + col] = f2bf(hv);
        } else {
            const int lr = lbase + crow(g, hi); float gate = 0.f; if (lr < cnt) gate = (e < 64) ? ((const float*)(p.ws + WS_ROWW))[e * S_ + lr] : 1.f;
            ((bf16_t*)(p.ws + WS_Y))[(size_t)row * D_ + col] = f2bf(v * gate);
        }
    }
}
__global__ void slow_scan(const float* flog, const float* fbias, float* cfn) {
    const int h = threadIdx.x; if (h >= NH) return;
    float a = 0.f; const float b = fbias[h];
    for (int t = 0; t < S_; ++t) { a += -softplusf(-(flog[(size_t)h * S_ + t] + b)); cfn[(size_t)h * S_ + t] = a; }
}
template <int MODE> __global__ __launch_bounds__(256) void slow_attn(const bf16_t* qkv, const bf16_t* kvmem, const float* cfn, bf16_t* ao) {
    __shared__ float qs[4][HD];
    const int wave = threadIdx.x >> 6, lane = threadIdx.x & 63;
    const int gw = blockIdx.x * 4 + wave, head = gw / S_, t = gw % S_;
    const int qh = (MODE == 2) ? 36 + head : head;
    const bf16_t* q = qkv + ((size_t)qh * S_ + t) * HD;
    const bf16_t* K = (MODE == 2) ? kvmem + (size_t)head * NMEM * HD : qkv + (size_t)(12 + head) * S_ * HD;
    const bf16_t* V = (MODE == 2) ? kvmem + (size_t)(4 + head) * NMEM * HD : qkv + (size_t)(24 + head) * S_ * HD;
    qs[wave][lane] = bf2f(q[lane]) * LN2; qs[wave][lane + 64] = bf2f(q[lane + 64]) * LN2;
    __syncthreads();
    const int nkeys = (MODE == 0) ? t : (MODE == 1 ? t + 1 : NMEM);
    const int nch = (nkeys + 63) >> 6;
    float o0 = 0.f, o1 = 0.f, carry = 0.f, mrun = -__builtin_inff(), lrun = 0.f;
    const float cft = (MODE == 1) ? cfn[(size_t)head * S_ + t] : 0.f;
    for (int ci = 0; ci < nch; ++ci) {
        const int c = (MODE == 0) ? nch - 1 - ci : ci; const int base = c * 64, key = base + lane; const bool valid = key < nkeys;
        float z = 0.f;
        if (valid) { const bf16_t* kr = K + (size_t)key * HD;
            for (int d8 = 0; d8 < 16; ++d8) { const bf16x8 kv = *(const bf16x8*)(kr + d8 * 8);
#pragma unroll
                for (int j = 0; j < 8; ++j) z += qs[wave][d8 * 8 + j] * bf2f((bf16_t)kv[j]); } }
        float w;
        if (MODE == 0) {
            const float ls = valid ? -softplusf(z) : 0.f; float s = ls;
#pragma unroll
            for (int off = 1; off < 64; off <<= 1) { const float v = __shfl_down(s, off); if (lane + off < 64) s += v; }
            const float la = s - ls + carry; w = valid ? expf(z + ls + la) : 0.f; carry += __shfl(s, 0);
        } else {
            float lg = valid ? z : -__builtin_inff(); if (MODE == 1 && valid) lg += cft - cfn[(size_t)head * S_ + key];
            const float mc = wave_max(lg), mn = fmaxf(mrun, mc), al = expf(mrun - mn);
            w = valid ? expf(lg - mn) : 0.f; lrun = lrun * al + wave_sum(w); o0 *= al; o1 *= al; mrun = mn;
        }
        for (int j = 0; j < 64; ++j) { if (base + j >= nkeys) break; const float wj = __shfl(w, j);
            const unsigned vv = *(const unsigned*)(V + (size_t)(base + j) * HD + 2 * lane);
            o0 += wj * __uint_as_float(vv << 16); o1 += wj * __uint_as_float(vv & 0xffff0000u); }
    }
    if (MODE != 0) { const float il = 1.f / lrun; o0 *= il; o1 *= il; }
    const int ocol = ((MODE == 2) ? 12 + head : head) * HD + 2 * lane;
    *(unsigned*)(ao + (size_t)t * D_ + ocol) = cvtpk(o0, o1);
}
__global__ __launch_bounds__(256) void slow_prep(const float* x, const float* mem, const float* g, const float* b, bf16_t* xb, bf16_t* memn) {
    const size_t n = (size_t)S_ * D_;
    for (size_t i = (size_t)blockIdx.x * 256 + threadIdx.x; i < n; i += (size_t)gridDim.x * 256) xb[i] = f2bf(x[i]);
    const int wave = threadIdx.x >> 6, lane = threadIdx.x & 63, gw = blockIdx.x * 4 + wave;
    if (gw < NMEM) { const float* row = mem + (size_t)gw * D_; float s = 0.f; for (int i = lane; i < D_; i += 64) s += row[i]; const float mean = wave_sum(s) / D_;
        float q = 0.f; for (int i = lane; i < D_; i += 64) { const float d = row[i] - mean; q += d * d; } const float rstd = 1.f / sqrtf(wave_sum(q) / D_ + LN_EPS);
        for (int i = lane; i < D_; i += 64) memn[(size_t)gw * D_ + i] = f2bf((row[i] - mean) * rstd * g[i] + b[i]); }
}

constexpr int NWAVES = 8;
constexpr int RING_BYTES = 131072, LDSCTL_OFF = RING_BYTES, MISC_OFF = LDSCTL_OFF + 1024;
constexpr int LDS_BYTES = 147456;
#define RLX_AGENT __ATOMIC_RELAXED, __HIP_MEMORY_SCOPE_AGENT
#define LDS_WAIT() asm volatile("s_waitcnt lgkmcnt(0)" ::: "memory")
#define VM_WAIT() asm volatile("s_waitcnt vmcnt(0)" ::: "memory")

#define XB_TMO      128
#define XB_XCNT(j)  (256  + 64 * (j))
#define XB_XSUB(j)  (1280 + 64 * (j))
#define XB_XGEN(j)  (2304 + 64 * (j))
#define XB_TOP      3328
#define XB_TOPGEN   3392
#define XCD_BAR_WORDS 3456
#define XB_SPIN_CAP (1u << 18)
__device__ __forceinline__ unsigned xb_ld(unsigned* p)              { return __hip_atomic_load(p, __ATOMIC_RELAXED, __HIP_MEMORY_SCOPE_AGENT); }
__device__ __forceinline__ unsigned xb_add(unsigned* p, unsigned v) { return __hip_atomic_fetch_add(p, v, __ATOMIC_RELAXED, __HIP_MEMORY_SCOPE_AGENT); }
__device__ __forceinline__ unsigned xb_xcc_id() { return (unsigned)__builtin_amdgcn_s_getreg((3 << 11) | 20) & 0xFu; }
#define XB_SPIN(cond, bar) do { unsigned _sp = 0; while (cond) { __builtin_amdgcn_s_sleep(1); \
    if ((++_sp & 255u) == 0u) { if (xb_ld(&(bar)[XB_TMO])) break; if (_sp > XB_SPIN_CAP) { atomicAdd(&(bar)[XB_TMO], 1u); break; } } } } while (0)
struct XcdBarrier { unsigned* bar; unsigned x; volatile LAS unsigned* st; };
__device__ __forceinline__ XcdBarrier xcd_barrier_post(unsigned* bar, volatile LAS unsigned* st) {
    XcdBarrier b; b.bar = bar; b.x = xb_xcc_id(); b.st = st;
    if (threadIdx.x == 0) (void)xb_add(&bar[XB_XCNT(b.x)], 1u);
    return b;
}
__device__ __forceinline__ void xcd_barrier_complete(unsigned* bar, unsigned x, unsigned& nloc, unsigned& nx) {
    const unsigned G = gridDim.x * gridDim.y * gridDim.z;
    unsigned sum, cnt, mine, sp = 0u;
    for (;;) {
        sum = 0u; cnt = 0u; mine = 0u;
#pragma unroll
        for (unsigned j = 0; j < 16; ++j) { const unsigned c = xb_ld(&bar[XB_XCNT(j)]); sum += c; cnt += (c > 0u) ? 1u : 0u; mine = (j == x) ? c : mine; }
        if (sum == G) break;
        __builtin_amdgcn_s_sleep(1);
        if ((++sp & 255u) == 0u) { if (xb_ld(&bar[XB_TMO])) break; if (sp > XB_SPIN_CAP) { atomicAdd(&bar[XB_TMO], 1u); break; } }
    }
    nloc = mine > 0u ? mine : 1u; nx = cnt > 0u ? cnt : 1u;
}
__device__ __forceinline__ void xcd_barrier(const XcdBarrier& b) {
    asm volatile("s_waitcnt vmcnt(0)" ::: "memory");
    __syncthreads();
    if (threadIdx.x == 0) {
        unsigned* bar = b.bar;
        __builtin_amdgcn_s_waitcnt(0);
        unsigned nloc = b.st[0], nx = b.st[1];
        if (nloc == 0u) { xcd_barrier_complete(bar, b.x, nloc, nx); b.st[0] = nloc; b.st[1] = nx; }
        const unsigned old = xb_add(&bar[XB_XSUB(b.x)], 1u);
        const unsigned gen = old / nloc;
        if (old + 1u == (gen + 1u) * nloc) {
            __builtin_amdgcn_fence(__ATOMIC_RELEASE, "agent");
            asm volatile("s_waitcnt vmcnt(0)" ::: "memory");
            const unsigned og = xb_add(&bar[XB_TOP], 1u);
            const unsigned tg = og / nx;
            if (og + 1u == (tg + 1u) * nx) xb_add(&bar[XB_TOPGEN], 1u);
            else XB_SPIN(xb_ld(&bar[XB_TOPGEN]) == tg, bar);
            __builtin_amdgcn_fence(__ATOMIC_ACQUIRE, "agent");
            xb_add(&bar[XB_XGEN(b.x)], 1u);
            asm volatile("s_waitcnt vmcnt(0)" ::: "memory");
        } else {
            XB_SPIN(xb_ld(&bar[XB_XGEN(b.x)]) == gen, bar);
            __builtin_amdgcn_fence(__ATOMIC_ACQUIRE, "agent");
            asm volatile("s_waitcnt vmcnt(0)" ::: "memory");
        }
    }
    __syncthreads();
}

__device__ __forceinline__ void build_prefix(LAS unsigned char* lds, const unsigned* gcnt) {
    LAS int* cntl = (LAS int*)(lds + LDSCTL_OFF); LAS int* tp = (LAS int*)(lds + LDSCTL_OFF + 512);
    const int tid = opaque_tid();
    if (tid < 64) cntl[tid] = (int)__hip_atomic_load(gcnt + tid, RLX_AGENT);
    if (tid == 64) cntl[64] = S_;
    __syncthreads();
    if (tid == 0) { int a = 0; for (int e = 0; e < 65; ++e) { tp[e] = a; a += (cntl[e] + 255) >> 8; } tp[65] = a; }
    __syncthreads();
}

__device__ __forceinline__ void phase_ln_router(LAS unsigned char* lds, unsigned char* ws, const float* g, const float* b, const float* Wr, const float* rbias, int L) {
    const int tid = opaque_tid(), lane = tid & 63, w = __builtin_amdgcn_readfirstlane(tid >> 6), r32 = lane & 31, hi = lane >> 5;
    const float* t1 = (const float*)(ws + WS_T1); float* x1f = (float*)(ws + WS_X1F); bf16_t* x1b = (bf16_t*)(ws + WS_X1B);
    int* tke = (int*)(ws + WS_TKE); int* tkp = (int*)(ws + WS_TKP); int* list = (int*)(ws + WS_LIST); float* roww = (float*)(ws + WS_ROWW);
    unsigned* gcnt = (unsigned*)(ws + WS_CTL) + CW_CNT + 64 * L;
    LAS float* part = (LAS float*)lds; LAS float* logits = (LAS float*)(lds + 65536);
    LAS int* lcnt = (LAS int*)(lds + 73728); LAS int* gbase = (LAS int*)(lds + 73728 + 256);
    LAS int* ent_e = (LAS int*)(lds + 74240); LAS float* ent_w = (LAS float*)(lds + 74240 + 1024); LAS int* ent_r = (LAS int*)(lds + 74240 + 2048);
    for (int rg = blockIdx.x; rg < S_ / 32; rg += gridDim.x) {
        if (tid < 64) lcnt[tid] = 0;
#pragma unroll 1
        for (int i = 0; i < 4; ++i) {
            const size_t row = (size_t)rg * 32 + w * 4 + i;
            const f32x4* tr = (const f32x4*)(t1 + row * D_) + lane; f32x4 v[8]; float s = 0.f;
#pragma unroll
            for (int j = 0; j < 8; ++j) { v[j] = tr[64 * j]; s += (v[j][0] + v[j][1]) + (v[j][2] + v[j][3]); }
            const float mean = wave_sum(s) * (1.f / D_); float q = 0.f;
#pragma unroll
            for (int j = 0; j < 8; ++j) { v[j] = v[j] - mean; q += (v[j][0] * v[j][0] + v[j][1] * v[j][1]) + (v[j][2] * v[j][2] + v[j][3] * v[j][3]); }
            const float rstd = 1.f / sqrtf(wave_sum(q) * (1.f / D_) + LN_EPS);
#pragma unroll
            for (int j = 0; j < 8; ++j) { const f32x4 gv = ((const f32x4*)g)[lane + 64 * j], bv = ((const f32x4*)b)[lane + 64 * j]; const f32x4 y = v[j] * rstd * gv + bv;
                ((f32x4*)(x1f + row * D_))[lane + 64 * j] = y; u32x2 pk = {cvtpk(y[0], y[1]), cvtpk(y[2], y[3])}; ((u32x2*)(x1b + row * D_))[lane + 64 * j] = pk; }
        }
        VM_WAIT(); __syncthreads();
        {
            f32x16 acc0 = {}, acc1 = {};
            const float* xr = x1f + ((size_t)rg * 32 + r32) * D_ + 256 * w + 4 * hi;
            const float* wr = Wr + (size_t)(256 * w + 4 * hi) * NE + r32;
#pragma unroll 4
            for (int q = 0; q < 32; ++q) { const f32x4 a4 = *(const f32x4*)(xr + 8 * q);
#pragma unroll
                for (int j = 0; j < 4; ++j) { const float b0 = wr[(8 * q + j) * NE], b1 = wr[(8 * q + j) * NE + 32];
                    acc0 = __builtin_amdgcn_mfma_f32_32x32x2f32(a4[j], b0, acc0, 0, 0, 0); acc1 = __builtin_amdgcn_mfma_f32_32x32x2f32(a4[j], b1, acc1, 0, 0, 0); } }
            LAS float* pw = part + w * 2048;
#pragma unroll
            for (int r = 0; r < 16; ++r) { pw[crow(r, hi) * 64 + r32] = acc0[r]; pw[crow(r, hi) * 64 + 32 + r32] = acc1[r]; }
        }
        __syncthreads();
        { const int tok = tid >> 4, e4 = (tid & 15) * 4; f32x4 s = {0.f, 0.f, 0.f, 0.f};
#pragma unroll
          for (int ww = 0; ww < 8; ++ww) s += *(const LAS f32x4*)(part + ww * 2048 + tok * 64 + e4);
          *(LAS f32x4*)(logits + tok * 64 + e4) = s; }
        __syncthreads();
        const float rb = rbias[lane];
#pragma unroll 1
        for (int i = 0; i < 4; ++i) {
            const int tok = w * 4 + i; const float x = logits[tok * 64 + lane];
            const float score = 1.f / (1.f + expf(-x)), sel = score + rb; const float NEG = -__builtin_inff();
            float m1 = sel; m1 = fmaxf(m1, __shfl_xor(m1, 1)); m1 = fmaxf(m1, __shfl_xor(m1, 2)); m1 = fmaxf(m1, __shfl_xor(m1, 4));
            const unsigned long long mk = __ballot(sel == m1); const unsigned grp = (unsigned)(mk >> (8 * (lane >> 3))) & 0xffu; const int first = __ffs((int)grp) - 1;
            float m2 = ((lane & 7) == first) ? NEG : sel; m2 = fmaxf(m2, __shfl_xor(m2, 1)); m2 = fmaxf(m2, __shfl_xor(m2, 2)); m2 = fmaxf(m2, __shfl_xor(m2, 4));
            const float gs = m1 + m2; int rank = 0;
#pragma unroll
            for (int g2 = 0; g2 < 8; ++g2) { const float og = __shfl(gs, g2 * 8); rank += (og > gs || (og == gs && g2 < (lane >> 3))) ? 1 : 0; }
            float mv = (rank < 4) ? sel : NEG; bool chosen = false;
#pragma unroll 1
            for (int it = 0; it < TOPK; ++it) { const float m = wave_max(mv); const unsigned long long cm = __ballot(mv == m); const int es = __ffsll((long long)cm) - 1; if (lane == es) { chosen = true; mv = NEG; } }
            const float wsum = wave_sum(chosen ? score : 0.f); const float wgt = score / wsum * 2.5f;
            const unsigned long long cmask = __ballot(chosen); const int kpos = __popcll(cmask & ((1ull << lane) - 1ull));
            if (chosen && kpos < TOPK) { const int lr = __hip_atomic_fetch_add((int*)(lcnt + lane), 1, __ATOMIC_RELAXED, __HIP_MEMORY_SCOPE_WORKGROUP);
                ent_e[tok * 8 + kpos] = lane; ent_w[tok * 8 + kpos] = wgt; ent_r[tok * 8 + kpos] = lr; }
        }
        __syncthreads();
        if (tid < 64) gbase[tid] = (int)__hip_atomic_fetch_add(gcnt + tid, (unsigned)lcnt[tid], RLX_AGENT);
        __syncthreads();
        if (tid < 256) { const int tok = tid >> 3, k = tid & 7, e = ent_e[tid], pos = gbase[e] + ent_r[tid]; const int t = rg * 32 + tok;
            tke[t * 8 + k] = e; tkp[t * 8 + k] = pos; roww[(size_t)e * S_ + pos] = ent_w[tid]; list[(size_t)e * S_ + pos] = t; }
        __syncthreads();
    }
}

__device__ __forceinline__ void phase_combine(LAS unsigned char* lds, unsigned char* ws, const float* g, const float* b, float* xo, bf16_t* xob, int L) {
    const int tid = opaque_tid(), lane = tid & 63, w = __builtin_amdgcn_readfirstlane(tid >> 6);
    build_prefix(lds, (const unsigned*)(ws + WS_CTL) + CW_CNT + 64 * L);
    const LAS int* tp = (const LAS int*)(lds + LDSCTL_OFF + 512);
    const float* x1f = (const float*)(ws + WS_X1F); const bf16_t* y = (const bf16_t*)(ws + WS_Y);
    const int* tke = (const int*)(ws + WS_TKE); const int* tkp = (const int*)(ws + WS_TKP);
    const int ysh = tp[64] * 256;
    for (int t = blockIdx.x * NWAVES + w; t < S_; t += gridDim.x * NWAVES) {
        int me = 0, mp = 0; if (lane < TOPK) { me = tke[t * 8 + lane]; mp = tkp[t * 8 + lane]; }
        const int myrow = (lane < TOPK) ? tp[me] * 256 + mp : ysh + t;
        f32x4 v[4][2];
#pragma unroll
        for (int j = 0; j < 4; ++j) { const float* xr = x1f + (size_t)t * D_ + 8 * lane + 512 * j; v[j][0] = *(const f32x4*)xr * ALPHA; v[j][1] = *(const f32x4*)(xr + 4) * ALPHA; }
#pragma unroll 1
        for (int k = 0; k < TOPK + 1; ++k) {
            const int yr = __shfl(myrow, k); const bf16_t* yp = y + (size_t)yr * D_ + 8 * lane;
#pragma unroll
            for (int j = 0; j < 4; ++j) { const u32x4 q = *(const u32x4*)(yp + 512 * j);
                v[j][0][0] += __uint_as_float(q[0] << 16); v[j][0][1] += __uint_as_float(q[0] & 0xffff0000u); v[j][0][2] += __uint_as_float(q[1] << 16); v[j][0][3] += __uint_as_float(q[1] & 0xffff0000u);
                v[j][1][0] += __uint_as_float(q[2] << 16); v[j][1][1] += __uint_as_float(q[2] & 0xffff0000u); v[j][1][2] += __uint_as_float(q[3] << 16); v[j][1][3] += __uint_as_float(q[3] & 0xffff0000u); }
        }
        float s = 0.f;
#pragma unroll
        for (int j = 0; j < 4; ++j) s += ((v[j][0][0] + v[j][0][1]) + (v[j][0][2] + v[j][0][3])) + ((v[j][1][0] + v[j][1][1]) + (v[j][1][2] + v[j][1][3]));
        const float mean = wave_sum(s) * (1.f / D_); float q2 = 0.f;
#pragma unroll
        for (int j = 0; j < 4; ++j) { v[j][0] = v[j][0] - mean; v[j][1] = v[j][1] - mean;
            q2 += ((v[j][0][0] * v[j][0][0] + v[j][0][1] * v[j][0][1]) + (v[j][0][2] * v[j][0][2] + v[j][0][3] * v[j][0][3])) + ((v[j][1][0] * v[j][1][0] + v[j][1][1] * v[j][1][1]) + (v[j][1][2] * v[j][1][2] + v[j][1][3] * v[j][1][3])); }
        const float rstd = 1.f / sqrtf(wave_sum(q2) * (1.f / D_) + LN_EPS);
#pragma unroll
        for (int j = 0; j < 4; ++j) { const int c = 8 * lane + 512 * j;
            const f32x4 y0 = v[j][0] * rstd * *(const f32x4*)(g + c) + *(const f32x4*)(b + c), y1 = v[j][1] * rstd * *(const f32x4*)(g + c + 4) + *(const f32x4*)(b + c + 4);
            *(f32x4*)(xo + (size_t)t * D_ + c) = y0; *(f32x4*)(xo + (size_t)t * D_ + c + 4) = y1;
            if (xob) { u32x4 pk = {cvtpk(y0[0], y0[1]), cvtpk(y0[2], y0[3]), cvtpk(y1[0], y1[1]), cvtpk(y1[2], y1[3])}; *(u32x4*)(xob + (size_t)t * D_ + c) = pk; } }
    }
}


__device__ __forceinline__ void conv_tile(const float* src, int ldN, bf16_t* dst, int ldK, int k0, int n0, int drow0, int nvalid, LAS unsigned char* scr, int lane) {
    const int q = lane >> 4, p = lane & 15;
    f32x4 v[16];
    const float* s0 = src + (size_t)(k0 + 16 * q) * ldN + n0 + 4 * p;
    const bool ok = 4 * p + 3 < nvalid;
#pragma unroll
    for (int i = 0; i < 16; ++i) v[i] = ok ? *(const f32x4*)(s0 + (size_t)i * ldN) : (f32x4){0.f, 0.f, 0.f, 0.f};
#pragma unroll
    for (int c = 0; c < 2; ++c)
#pragma unroll
        for (int j = 0; j < 4; ++j) { u32x4 w = {cvtpk(v[8 * c + 0][j], v[8 * c + 1][j]), cvtpk(v[8 * c + 2][j], v[8 * c + 3][j]), cvtpk(v[8 * c + 4][j], v[8 * c + 5][j]), cvtpk(v[8 * c + 6][j], v[8 * c + 7][j])};
            *(LAS u32x4*)(scr + (4 * p + j) * 144 + (16 * q + 8 * c) * 2) = w; }
    LDS_WAIT(); asm volatile("" ::: "memory");
#pragma unroll
    for (int i = 0; i < 8; ++i) { const int n = (lane >> 3) + 8 * i; const u32x4 w = *(const LAS u32x4*)(scr + n * 144 + (lane & 7) * 16);
        if (n < nvalid) *(u32x4*)(dst + (size_t)(drow0 + n) * ldK + k0 + 8 * (lane & 7)) = w; }
    LDS_WAIT(); asm volatile("" ::: "memory");
}
struct ConvJob { const float* src; bf16_t* dst; int K, N, nb, gu; size_t dstride; };
__device__ __forceinline__ int conv_tiles(const ConvJob& j) { return j.nb * (j.K / 64) * ((j.N + 63) / 64); }
__device__ __forceinline__ void conv_run(const ConvJob& j, int t, LAS unsigned char* scr, int lane) {
    const int ntn = (j.N + 63) / 64, ntk = j.K / 64, per = ntk * ntn;
    const int bi = t / per, r = t - bi * per, kt = r / ntn, nt = r - kt * ntn;
    const int n0 = nt * 64; int nvalid = j.N - n0; if (nvalid > 64) nvalid = 64;
    int drow0 = n0; if (j.gu) drow0 = 256 * ((n0 & 511) >> 7) + 128 * (n0 >> 9) + (n0 & 127);
    conv_tile(j.src + (size_t)bi * j.K * j.N, j.N, j.dst + (size_t)bi * j.dstride, j.K, kt * 64, n0, drow0, nvalid, scr, lane);
}
__device__ __forceinline__ void phase_prologue(LAS unsigned char* lds, const Args& a) {
    const int tid = opaque_tid(), lane = tid & 63, w = __builtin_amdgcn_readfirstlane(tid >> 6);
    unsigned char* ws = a.ws;
    const int gw = blockIdx.x * NWAVES + w, NGW = gridDim.x * NWAVES;
    LAS unsigned char* scr = lds + w * 9216;
    { const f32x4* x4 = (const f32x4*)a.in[0]; u32x2* o = (u32x2*)(ws + WS_XB); const size_t n4 = (size_t)S_ * D_ / 4;
      for (size_t i = (size_t)blockIdx.x * 512 + tid; i < n4; i += (size_t)gridDim.x * 512) { const f32x4 v = x4[i]; u32x2 pk = {cvtpk(v[0], v[1]), cvtpk(v[2], v[3])}; o[i] = pk; } }
    for (int m = gw; m < NMEM; m += NGW) { const f32x4* tr = (const f32x4*)(a.in[1] + (size_t)m * D_) + lane; f32x4 v[8]; float s = 0.f;
#pragma unroll
        for (int j = 0; j < 8; ++j) { v[j] = tr[64 * j]; s += (v[j][0] + v[j][1]) + (v[j][2] + v[j][3]); }
        const float mean = wave_sum(s) * (1.f / D_); float q = 0.f;
#pragma unroll
        for (int j = 0; j < 8; ++j) { v[j] = v[j] - mean; q += (v[j][0] * v[j][0] + v[j][1] * v[j][1]) + (v[j][2] * v[j][2] + v[j][3] * v[j][3]); }
        const float rstd = 1.f / sqrtf(wave_sum(q) * (1.f / D_) + LN_EPS);
#pragma unroll
        for (int j = 0; j < 8; ++j) { const f32x4 y = v[j] * rstd * ((const f32x4*)a.in[2])[lane + 64 * j] + ((const f32x4*)a.in[3])[lane + 64 * j];
            u32x2 pk = {cvtpk(y[0], y[1]), cvtpk(y[2], y[3])}; ((u32x2*)(ws + WS_MEMN + (size_t)m * D_ * 2))[lane + 64 * j] = pk; } }
    { u32x4* z = (u32x4*)(ws + WS_WIN1 + (size_t)NQKV1 * D_ * 2); const size_t n = (size_t)(NQKV1P - NQKV1) * D_ * 2 / 16;
      for (size_t i = (size_t)blockIdx.x * 512 + tid; i < n; i += (size_t)gridDim.x * 512) z[i] = (u32x4){0u, 0u, 0u, 0u}; }
    ConvJob jobs[13];
    jobs[0] = ConvJob{a.in[5], (bf16_t*)(ws + WS_WIN0), D_, NQKV0, 1, 0, 0};
    jobs[1] = ConvJob{a.in[4], (bf16_t*)(ws + WS_WMEM), D_, 1024, 1, 0, 0};
    jobs[2] = ConvJob{a.in[6], (bf16_t*)(ws + WS_WO0), D_, D_, 1, 0, 0};
    jobs[3] = ConvJob{a.in[11], (bf16_t*)(ws + WS_WGU0), D_, 1024, 64, 1, (size_t)1024 * D_};
    jobs[4] = ConvJob{a.in[13], (bf16_t*)(ws + WS_WGU0) + (size_t)64 * 1024 * D_, D_, 1024, 1, 1, 0};
    jobs[5] = ConvJob{a.in[12], (bf16_t*)(ws + WS_WD0), EFF, D_, 64, 0, (size_t)D_ * EFF};
    jobs[6] = ConvJob{a.in[14], (bf16_t*)(ws + WS_WD0) + (size_t)64 * D_ * EFF, EFF, D_, 1, 0, 0};
    jobs[7] = ConvJob{a.in[17], (bf16_t*)(ws + WS_WIN1), D_, NQKV1, 1, 0, 0};
    jobs[8] = ConvJob{a.in[19], (bf16_t*)(ws + WS_WO1), D_, D_, 1, 0, 0};
    jobs[9] = ConvJob{a.in[24], (bf16_t*)(ws + WS_WGU1), D_, 1024, 64, 1, (size_t)1024 * D_};
    jobs[10] = ConvJob{a.in[26], (bf16_t*)(ws + WS_WGU1) + (size_t)64 * 1024 * D_, D_, 1024, 1, 1, 0};
    jobs[11] = ConvJob{a.in[25], (bf16_t*)(ws + WS_WD1), EFF, D_, 64, 0, (size_t)D_ * EFF};
    jobs[12] = ConvJob{a.in[27], (bf16_t*)(ws + WS_WD1) + (size_t)64 * D_ * EFF, EFF, D_, 1, 0, 0};
#pragma unroll
    for (int ji = 0; ji < 13; ++ji) { const int nt = conv_tiles(jobs[ji]);
        for (int t = gw; t < nt; t += NGW) conv_run(jobs[ji], t, scr, lane); }
}

namespace pg8 {
constexpr int BM = 256, BK = 64, HALF = 128, HTB = HALF * BK * 2, STAGE_BYTES = 8 * HTB, NXCD = 8, WGM = 8;
__host__ __device__ __forceinline__ int lds_byte(int r, int c) { const int st = (r >> 4) * 2 + (c >> 5), rr = r & 15, cc = c & 31, ob = rr * 64 + cc * 2; return st * 1024 + (ob ^ (((ob >> 9) & 1) << 5)); }
__host__ __device__ __forceinline__ void stage_rc(int b, int& R, int& C) { const int st = b / 1024, sb = b % 1024, swz = sb ^ (((sb >> 9) & 1) << 5); R = (st >> 1) * 16 + swz / 64; C = (st & 1) * 32 + (swz % 64) / 2; }
__host__ __device__ __forceinline__ int perm32(int rho) { const int n = rho >> 4, i = rho & 15; return 8 * (i >> 2) + 4 * n + (i & 3); }
struct Unit { int pm, pn, e, cnt, orow; };
struct PlainOrder {
    static constexpr bool GATHER = false;
    const bf16_t* A; const bf16_t* Bt; int K; int nM, nN, nwg, G, c;
    __device__ void init(const bf16_t* A_, const bf16_t* Bt_, int M, int N, int K_, int G_, int c_) { A = A_; Bt = Bt_; K = K_; nM = M / BM; nN = N / BM; nwg = nM * nN; G = G_; c = c_; }
    __device__ bool next(int i, Unit& u) const {
        const long L = (long)i * G + c; if (c < 0 || L >= nwg) return false;
        int wgid = (int)L; { const int q = nwg / NXCD, r = nwg % NXCD, xcd = wgid % NXCD, off = wgid / NXCD; wgid = (xcd < r ? xcd * (q + 1) : r * (q + 1) + (xcd - r) * q) + off; }
        const int nig = WGM * nN, gid = wgid / nig, fm = gid * WGM, gsz = (nM - fm) < WGM ? (nM - fm) : WGM;
        u.pm = fm + ((wgid % nig) % gsz); u.pn = (wgid % nig) / gsz; u.e = 0; u.cnt = 0; u.orow = u.pm * BM; return true;
    }
    __device__ __forceinline__ const char* a_base(const Unit& u) const { return (const char*)A + (size_t)u.pm * BM * K * 2; }
    __device__ __forceinline__ const char* b_base(const Unit& u) const { return (const char*)Bt + (size_t)u.pn * BM * K * 2; }
    __device__ __forceinline__ void gather_offs(const Unit&, int, int, int, int, unsigned (&)[4]) const {}
};
template <bool GATHER_> struct GroupedOrder {
    static constexpr bool GATHER = GATHER_;
    const bf16_t* A; const bf16_t* Bt; int K, Nexp  , npn, G, c; const LAS int* tp; const LAS int* cntl; const int* list;
    __device__ bool next(int i, Unit& u) const {
        const int L = i * G + c, total = tp[65] * npn; if (L >= total) return false;
        const int tile = L / npn; u.pn = L - tile * npn; int e = 0;
        while (tp[e + 1] <= tile) ++e;
        u.e = e; u.pm = tile - tp[e]; u.cnt = cntl[e]; u.orow = tile * BM; return true;
    }
    __device__ __forceinline__ const char* a_base(const Unit& u) const { return GATHER ? (const char*)A : (const char*)A + (size_t)u.orow * K * 2; }
    __device__ __forceinline__ const char* b_base(const Unit& u) const { return (const char*)Bt + ((size_t)u.e * Nexp + (size_t)u.pn * BM) * K * 2; }
    __device__ __forceinline__ void gather_offs(const Unit& u, int R0, int C0, int R1, int C1, unsigned (&vo)[4]) const {
#pragma unroll
        for (int h = 0; h < 2; ++h) { const int l0 = u.pm * BM + h * HALF + R0, l1 = u.pm * BM + h * HALF + R1; int t0 = 0, t1 = 0;
            if (u.e < 64) { if (l0 < u.cnt) t0 = list[(size_t)u.e * S_ + l0]; if (l1 < u.cnt) t1 = list[(size_t)u.e * S_ + l1]; } else { t0 = l0; t1 = l1; }
            vo[2 * h] = (unsigned)(t0 * K + C0) * 2u; vo[2 * h + 1] = (unsigned)(t1 * K + C1) * 2u; }
    }
};

template <class Epi, class Sched>
__device__ __forceinline__ void gemm_phase(LAS unsigned char* lds, const Sched& S, const Epi& E) {
    constexpr bool GA = Sched::GATHER;
    const int tid = opaque_tid(), wid = __builtin_amdgcn_readfirstlane(tid >> 6), lane = tid & 63, wr = wid >> 2, wc = wid & 3, fr = lane & 15, fq = lane >> 4;
    const int K = S.K, nt = K / BK;
    unsigned voffA[2], voffB[2]; int Rs[2], Cs[2];
#pragma unroll
    for (int i = 0; i < 2; ++i) { int R, C; stage_rc(tid * 16 + i * 8192, R, C); Rs[i] = R; Cs[i] = C; const int Rb = Epi::PERM ? ((R & ~31) + perm32(R & 31)) : R;
        voffA[i] = (unsigned)(R * K + C) * 2u; voffB[i] = (unsigned)(Rb * K + C) * 2u; }
    const size_t kstep = (size_t)(BK * 2);
    const size_t hstep = (size_t)HALF * K * 2;
    const unsigned ldsw = (unsigned)wid * 1024u;
    const int aoff = lds_byte(wr * 64 + fr, fq * 8), boff = lds_byte(wc * 32 + fr, fq * 8);
#define PG8_SA(b, h) (((b) * 2 + (h)) * HTB)
#define PG8_SB(b, h) ((4 + (b) * 2 + (h)) * HTB)
#define PG8_GLDS(bufoff, gptr, off, i_) __builtin_amdgcn_global_load_lds((const unsigned*)((const char*)(gptr) + (off)), (LAS unsigned*)(lds + (bufoff) + ldsw + (i_) * 8192), 16, 0, 0)
#define PG8_STAGE_B(bufoff, gbase) do { PG8_GLDS(bufoff, gbase, voffB[0], 0); PG8_GLDS(bufoff, gbase, voffB[1], 1); } while (0)
#define PG8_STAGE_A(bufoff, kptr, h, nx) do { if constexpr (GA) { PG8_GLDS(bufoff, kptr, (nx) ? vgn[2 * (h)] : vgc[2 * (h)], 0); PG8_GLDS(bufoff, kptr, (nx) ? vgn[2 * (h) + 1] : vgc[2 * (h) + 1], 1); } \
        else { PG8_GLDS(bufoff, (kptr) + (h) * hstep, voffA[0], 0); PG8_GLDS(bufoff, (kptr) + (h) * hstep, voffA[1], 1); } } while (0)
#define PG8_LDA(dst, b, h) do { _Pragma("unroll") for (int m = 0; m < 4; ++m) _Pragma("unroll") for (int k = 0; k < 2; ++k) dst[m][k] = *(const LAS bf16x8*)(lds + PG8_SA(b, h) + aoff + m * 2048 + k * 1024); } while (0)
#define PG8_LDB(dst, b, h) do { _Pragma("unroll") for (int n = 0; n < 2; ++n) _Pragma("unroll") for (int k = 0; k < 2; ++k) dst[n][k] = *(const LAS bf16x8*)(lds + PG8_SB(b, h) + boff + n * 2048 + k * 1024); } while (0)
#define PG8_MMA(ai, bj, At, Bt) do { __builtin_amdgcn_s_setprio(1); _Pragma("unroll") for (int m = 0; m < 4; ++m) _Pragma("unroll") for (int n = 0; n < 2; ++n) _Pragma("unroll") for (int k = 0; k < 2; ++k) \
        acc[ai][bj][m][n] = __builtin_amdgcn_mfma_f32_16x16x32_bf16(Bt[n][k], At[m][k], acc[ai][bj][m][n], 0, 0, 0); __builtin_amdgcn_s_setprio(0); } while (0)
#define PG8_WAIT_V(n) asm volatile("s_waitcnt vmcnt(" #n ")" ::: "memory")
#define PG8_WAIT_L(n) asm volatile("s_waitcnt lgkmcnt(" #n ")" ::: "memory")
#define PG8_BAR __builtin_amdgcn_s_barrier()
#define PG8_SCHED __builtin_amdgcn_sched_barrier(0)
    Unit cur, nxt; int ui = 0;
    if (!S.next(0, cur)) return;
    f32x4 acc[2][2][4][2];
#pragma unroll
    for (int a = 0; a < 2; ++a)
#pragma unroll
        for (int b = 0; b < 2; ++b)
#pragma unroll
            for (int m = 0; m < 4; ++m)
#pragma unroll
                for (int n = 0; n < 2; ++n) acc[a][b][m][n] = (f32x4){0.f, 0.f, 0.f, 0.f};
    bf16x8 At[4][2], B0[2][2], B1[2][2];
    unsigned vgc[4] = {0u, 0u, 0u, 0u}, vgn[4] = {0u, 0u, 0u, 0u};
    if constexpr (GA) S.gather_offs(cur, Rs[0], Cs[0], Rs[1], Cs[1], vgc);
    const char* cA = S.a_base(cur); const char* cB = S.b_base(cur);
    PG8_STAGE_B(PG8_SB(0, 0), cB); PG8_STAGE_B(PG8_SB(0, 1), cB + hstep); PG8_STAGE_A(PG8_SA(0, 0), cA, 0, false); PG8_STAGE_A(PG8_SA(0, 1), cA, 1, false);
    if (wr == 1) PG8_BAR;
    PG8_WAIT_V(2); PG8_BAR;
    PG8_STAGE_B(PG8_SB(1, 0), cB + kstep); PG8_STAGE_A(PG8_SA(1, 0), cA + kstep, 0, false); PG8_STAGE_B(PG8_SB(1, 1), cB + hstep + kstep);
    PG8_WAIT_V(6); PG8_BAR;
    for (;;) {
        const bool has_next = S.next(ui + 1, nxt);
        if constexpr (GA) { if (has_next) S.gather_offs(nxt, Rs[0], Cs[0], Rs[1], Cs[1], vgn); }
        const char* nA = has_next ? S.a_base(nxt) : cA; const char* nB = has_next ? S.b_base(nxt) : cB;
        for (int t = 0; t < nt; t += 2) {
            const bool last = (t == nt - 2);
            const bool nx = last && has_next;
            const char* a1 = cA + (size_t)(t + 1) * kstep;
            const char* a2 = last ? nA : cA + (size_t)(t + 2) * kstep; const char* b2 = last ? nB : cB + (size_t)(t + 2) * kstep;
            const char* a3 = a2 + kstep; const char* b3 = b2 + kstep;
            PG8_LDB(B0, 0, 0); PG8_LDB(B1, 0, 1); PG8_SCHED; PG8_LDA(At, 0, 0); PG8_STAGE_A(PG8_SA(1, 1), a1, 1, false);
            PG8_WAIT_V(8); PG8_WAIT_L(0); PG8_BAR; PG8_MMA(0, 0, At, B0); PG8_MMA(0, 1, At, B1); PG8_BAR; PG8_SCHED;
            PG8_LDA(At, 0, 1); PG8_STAGE_B(PG8_SB(0, 0), b2); PG8_STAGE_B(PG8_SB(0, 1), b2 + hstep); PG8_STAGE_A(PG8_SA(0, 0), a2, 0, nx);
            PG8_WAIT_V(8); PG8_WAIT_L(0); PG8_BAR; PG8_MMA(1, 0, At, B0); PG8_MMA(1, 1, At, B1); PG8_BAR; PG8_SCHED;
            PG8_LDB(B0, 1, 0); PG8_LDB(B1, 1, 1); PG8_SCHED; PG8_LDA(At, 1, 0); PG8_STAGE_A(PG8_SA(0, 1), a2, 1, nx);
            PG8_WAIT_V(8); PG8_WAIT_L(0); PG8_BAR; PG8_MMA(0, 0, At, B0); PG8_MMA(0, 1, At, B1); PG8_BAR; PG8_SCHED;
            PG8_LDA(At, 1, 1); PG8_STAGE_B(PG8_SB(1, 0), b3); PG8_STAGE_B(PG8_SB(1, 1), b3 + hstep); PG8_STAGE_A(PG8_SA(1, 0), a3, 0, nx);
            PG8_WAIT_V(8); PG8_WAIT_L(0); PG8_BAR; PG8_MMA(1, 0, At, B0); PG8_MMA(1, 1, At, B1); PG8_BAR; PG8_SCHED;
        }
        if (wr == 0) PG8_BAR;
        E(acc, cur, wr, wc, fr, fq);
        if (!has_next) break;
#pragma unroll
        for (int a = 0; a < 2; ++a)
#pragma unroll
            for (int b = 0; b < 2; ++b)
#pragma unroll
                for (int m = 0; m < 4; ++m)
#pragma unroll
                    for (int n = 0; n < 2; ++n) acc[a][b][m][n] = (f32x4){0.f, 0.f, 0.f, 0.f};
        cur = nxt; cA = nA; cB = nB; ++ui;
        if constexpr (GA) {
#pragma unroll
            for (int i = 0; i < 4; ++i) vgc[i] = vgn[i]; }
        if (wr == 1) PG8_BAR;
    }
    PG8_WAIT_V(0);
    PG8_BAR;
#undef PG8_SA
#undef PG8_SB
#undef PG8_GLDS
#undef PG8_STAGE_A
#undef PG8_STAGE_B
#undef PG8_LDA
#undef PG8_LDB
#undef PG8_MMA
#undef PG8_WAIT_V
#undef PG8_WAIT_L
#undef PG8_BAR
#undef PG8_SCHED
}

struct EpiHead {
    static constexpr bool PERM = true;
    bf16_t* dst; int rows; int nheads; int qscale; float* flog;
    __device__ __forceinline__ void operator()(const f32x4 (&acc)[2][2][4][2], const Unit& u, int wr, int wc, int fr, int fq) const {
#pragma unroll
        for (int bj = 0; bj < 2; ++bj) { const int head = 2 * u.pn + bj;
            if (head < nheads) { const float sc = (qscale && (head < 12 || head >= 36)) ? QSCALE : 1.f;
                bf16_t* base = dst + (size_t)head * rows * HD + wc * 32 + 8 * fq;
#pragma unroll
                for (int ai = 0; ai < 2; ++ai)
#pragma unroll
                    for (int m = 0; m < 4; ++m) { const int row = u.orow + ai * HALF + wr * 64 + m * 16 + fr; const f32x4 v0 = acc[ai][bj][m][0] * sc, v1 = acc[ai][bj][m][1] * sc;
                        u32x4 w = {cvtpk(v0[0], v0[1]), cvtpk(v0[2], v0[3]), cvtpk(v1[0], v1[1]), cvtpk(v1[2], v1[3])}; *(u32x4*)(base + (size_t)row * HD) = w; } }
            else if (flog && head == nheads && wc == 0 && fq < 2) {
#pragma unroll
                for (int ai = 0; ai < 2; ++ai)
#pragma unroll
                    for (int m = 0; m < 4; ++m) { const int row = u.orow + ai * HALF + wr * 64 + m * 16 + fr;
#pragma unroll
                        for (int n = 0; n < 2; ++n)
#pragma unroll
                            for (int j = 0; j < 4; ++j) { const int c = 8 * fq + 4 * n + j; if (c < NH) flog[(size_t)c * S_ + row] = acc[ai][bj][m][n][j]; } } }
        }
    }
};
struct EpiT1 {
    static constexpr bool PERM = false;
    const float* x; float* t1;
    __device__ __forceinline__ void operator()(const f32x4 (&acc)[2][2][4][2], const Unit& u, int wr, int wc, int fr, int fq) const {
        const int col0 = u.pn * BM + wc * 32 + 4 * fq;
#pragma unroll
        for (int ai = 0; ai < 2; ++ai)
#pragma unroll
            for (int m = 0; m < 4; ++m) { const size_t off = (size_t)(u.orow + ai * HALF + wr * 64 + m * 16 + fr) * D_ + col0;
#pragma unroll
                for (int bj = 0; bj < 2; ++bj)
#pragma unroll
                    for (int n = 0; n < 2; ++n) { const f32x4 xs = *(const f32x4*)(x + off + bj * HALF + n * 16); *(f32x4*)(t1 + off + bj * HALF + n * 16) = xs * ALPHA + acc[ai][bj][m][n]; }
                if (m & 1) asm volatile("" ::: "memory"); }
    }
};
struct EpiGU {
    static constexpr bool PERM = true;
    bf16_t* h;
    __device__ __forceinline__ void operator()(const f32x4 (&acc)[2][2][4][2], const Unit& u, int wr, int wc, int fr, int fq) const {
        bf16_t* base = h + u.pn * HALF + wc * 32 + 8 * fq;
#pragma unroll
        for (int ai = 0; ai < 2; ++ai)
#pragma unroll
            for (int m = 0; m < 4; ++m) { const int row = u.orow + ai * HALF + wr * 64 + m * 16 + fr; float o[8];
#pragma unroll
                for (int n = 0; n < 2; ++n)
#pragma unroll
                    for (int j = 0; j < 4; ++j) { const float g = acc[ai][0][m][n][j], up = acc[ai][1][m][n][j];
                        o[4 * n + j] = g * __builtin_amdgcn_rcpf(1.f + __builtin_amdgcn_exp2f(-g * LOG2E)) * up; }
                u32x4 w = {cvtpk(o[0], o[1]), cvtpk(o[2], o[3]), cvtpk(o[4], o[5]), cvtpk(o[6], o[7])}; *(u32x4*)(base + (size_t)row * EFF) = w; }
    }
};
struct EpiDown {
    static constexpr bool PERM = true;
    bf16_t* y; const float* roww;
    __device__ __forceinline__ void operator()(const f32x4 (&acc)[2][2][4][2], const Unit& u, int wr, int wc, int fr, int fq) const {
        bf16_t* base = y + u.pn * BM + wc * 32 + 8 * fq;
#pragma unroll
        for (int ai = 0; ai < 2; ++ai)
#pragma unroll
            for (int m = 0; m < 4; ++m) { const int lr = u.pm * BM + ai * HALF + wr * 64 + m * 16 + fr; const int row = u.orow + ai * HALF + wr * 64 + m * 16 + fr;
                float gt = 0.f; if (lr < u.cnt) gt = (u.e < 64) ? roww[(size_t)u.e * S_ + lr] : 1.f;
#pragma unroll
                for (int bj = 0; bj < 2; ++bj) { const f32x4 v0 = acc[ai][bj][m][0] * gt, v1 = acc[ai][bj][m][1] * gt;
                    u32x4 w = {cvtpk(v0[0], v0[1]), cvtpk(v0[2], v0[3]), cvtpk(v1[0], v1[1]), cvtpk(v1[2], v1[3])}; *(u32x4*)(base + (size_t)row * D_ + bj * HALF) = w; } }
    }
};
}


namespace at {
constexpr int NW = 8, QBLK = 32, KVBLK = 64, QB = NW * QBLK, SHM_V = KVBLK * HD * 2, SHM_K = KVBLK * HD * 2;
constexpr int WS_OFF = 2 * SHM_V + 2 * SHM_K, TAB_OFF = WS_OFF + NW * 64 * 4, ZERO_OFF = TAB_OFF + S_ * 4, ATT_END = ZERO_OFF + 1024;
constexpr float THR = 8.f;
static_assert(ATT_END <= RING_BYTES, "attention LDS");
#define KSWZ(row, colB) ((row) * 256 + ((colB) ^ (((row) & 7) << 4)))
#define SBAR() __builtin_amdgcn_sched_barrier(0)
__device__ __forceinline__ int v_st(int k, int c) { const int kk = (k & ~0xC) | ((k & 4) << 1) | ((k & 8) >> 1); return ((kk >> 3) * 4 + (c >> 5)) * 512 + ((kk & 7) * 32 + (c & 31)) * 2; }
__device__ __forceinline__ int v_rd_base(int lane) { return ((lane & 3) << 3) | (((lane >> 2) & 3) << 6) | (((lane >> 4) & 1) << 5) | (((lane >> 5) & 1) << 8); }
constexpr int v_rd_off(int d0, int ks, int half) { return d0 * 512 + ks * 4096 + half * 2048; }
__device__ __forceinline__ bf16x8 load8(const bf16_t* p) { return *reinterpret_cast<const bf16x8*>(p); }
__device__ __forceinline__ void mask_tile(f32x16& p0, f32x16& p1, int dq, unsigned W) {
    const float NEG = -__builtin_inff();
#pragma unroll
    for (int r = 0; r < 16; ++r) { const int c = (r & 3) + 8 * (r >> 2);
        if ((unsigned)(dq - c) >= W) p0[r] = NEG;
        if ((unsigned)(dq - c - 32) >= W) p1[r] = NEG; }
}
#define PK4(P, B_, OUT) do { unsigned a0 = cvtpk(P[B_+0], P[B_+1]), a1 = cvtpk(P[B_+2], P[B_+3]);                          \
        unsigned b0 = cvtpk(P[B_+4], P[B_+5]), b1 = cvtpk(P[B_+6], P[B_+7]);                                             \
        auto r0 = __builtin_amdgcn_permlane32_swap(a0, b0, false, false); auto r1 = __builtin_amdgcn_permlane32_swap(a1, b1, false, false); \
        u32x4 w = {r0[0], r1[0], r0[1], r1[1]}; OUT = *reinterpret_cast<bf16x8*>(&w); } while (0)
__device__ __forceinline__ void partialSM(f32x16& p0, f32x16& p1, float& m_reg, float& mn, float& alpha) {
    float pmax = p0[0];
#pragma unroll
    for (int r = 1; r < 16; ++r) pmax = fmaxf(pmax, p0[r]);
#pragma unroll
    for (int r = 0; r < 16; ++r) pmax = fmaxf(pmax, p1[r]);
    { auto rr = __builtin_amdgcn_permlane32_swap(__float_as_uint(pmax), __float_as_uint(pmax), false, false);
      pmax = fmaxf(__uint_as_float(rr[0]), __uint_as_float(rr[1])); }
    if (__builtin_expect(__all((pmax - m_reg) <= THR), 1)) { mn = m_reg; alpha = 1.f; }
    else { mn = fmaxf(m_reg, pmax); alpha = __builtin_amdgcn_exp2f(m_reg - mn); m_reg = mn; }
#pragma unroll
    for (int r = 0; r < 16; ++r) p0[r] = p0[r] - mn;
#pragma unroll
    for (int r = 0; r < 16; ++r) p1[r] = p1[r] - mn;
#pragma unroll
    for (int r = 0; r < 16; ++r) p0[r] = __builtin_amdgcn_exp2f(p0[r]);
}
__device__ __forceinline__ void finishSM(f32x16& p0, f32x16& p1, float alpha, float& l_reg, bf16x8& pa0, bf16x8& pa1, bf16x8& pa2, bf16x8& pa3) {
#pragma unroll
    for (int r = 0; r < 16; ++r) p1[r] = __builtin_amdgcn_exp2f(p1[r]);
    float ps = 0;
#pragma unroll
    for (int r = 0; r < 16; ++r) ps += p0[r];
#pragma unroll
    for (int r = 0; r < 16; ++r) ps += p1[r];
    { auto rr = __builtin_amdgcn_permlane32_swap(__float_as_uint(ps), __float_as_uint(ps), false, false);
      ps = __uint_as_float(rr[0]) + __uint_as_float(rr[1]); }
    l_reg = l_reg * alpha + ps;
    PK4(p0, 0, pa0); PK4(p0, 8, pa1); PK4(p1, 0, pa2); PK4(p1, 8, pa3);
}
__device__ __forceinline__ void partialSB(f32x16& p0, f32x16& p1, float (&E)[8], float& tot, int hi) {
#pragma unroll
    for (int r = 0; r < 16; ++r) p0[r] = __builtin_amdgcn_rcpf(1.f + __builtin_amdgcn_exp2f(p0[r]));
#pragma unroll
    for (int r = 0; r < 16; ++r) p1[r] = __builtin_amdgcn_rcpf(1.f + __builtin_amdgcn_exp2f(p1[r]));
    float Glo[8], Ghi[8];
#pragma unroll
    for (int m = 0; m < 8; ++m) { const int b = 4 * (m & 3); const float G = (m < 4) ? (p0[b] * p0[b + 1]) * (p0[b + 2] * p0[b + 3]) : (p1[b] * p1[b + 1]) * (p1[b + 2] * p1[b + 3]);
        auto rr = __builtin_amdgcn_permlane32_swap(__float_as_uint(G), __float_as_uint(G), false, false); Glo[m] = __uint_as_float(rr[0]); Ghi[m] = __uint_as_float(rr[1]); }
    float st = 1.f;
#pragma unroll
    for (int m = 7; m >= 0; --m) { const float e1 = st * Ghi[m]; E[m] = hi ? st : e1; st = e1 * Glo[m]; }
    tot = st;
}
__device__ __forceinline__ void finishSB(f32x16& p0, f32x16& p1, const float (&E)[8], float tot, float& R, bf16x8& pa0, bf16x8& pa1, bf16x8& pa2, bf16x8& pa3) {
#pragma unroll
    for (int m = 0; m < 8; ++m) { const int b = 4 * (m & 3); float a = E[m] * R;
        if (m < 4) { const float w3 = fmaf(-a, p0[b + 3], a); a *= p0[b + 3]; const float w2 = fmaf(-a, p0[b + 2], a); a *= p0[b + 2]; const float w1 = fmaf(-a, p0[b + 1], a); a *= p0[b + 1]; const float w0 = fmaf(-a, p0[b], a);
            p0[b] = w0; p0[b + 1] = w1; p0[b + 2] = w2; p0[b + 3] = w3; }
        else { const float w3 = fmaf(-a, p1[b + 3], a); a *= p1[b + 3]; const float w2 = fmaf(-a, p1[b + 2], a); a *= p1[b + 2]; const float w1 = fmaf(-a, p1[b + 1], a); a *= p1[b + 1]; const float w0 = fmaf(-a, p1[b], a);
            p1[b] = w0; p1[b + 1] = w1; p1[b + 2] = w2; p1[b + 3] = w3; } }
    R *= tot;
    PK4(p0, 0, pa0); PK4(p0, 8, pa1); PK4(p1, 0, pa2); PK4(p1, 8, pa3);
}
#undef PK4
template <int KB, int MODE>
__device__ __forceinline__ void qkt(f32x16& p0, f32x16& p1, const char* K_lds, int r32, int hi, const bf16x8* qr, const float* tabk) {
    if (MODE == 1) {
#pragma unroll
        for (int m = 0; m < 4; ++m) { const f32x4 a = *(const f32x4*)(tabk + 8 * m), b = *(const f32x4*)(tabk + 32 + 8 * m);
#pragma unroll
            for (int j = 0; j < 4; ++j) { p0[4 * m + j] = a[j]; p1[4 * m + j] = b[j]; } }
    } else { p0 = f32x16{}; p1 = f32x16{}; }
    const char* kb[4];
#pragma unroll
    for (int dd = 0; dd < 4; ++dd) kb[dd] = K_lds + KB * SHM_K + KSWZ(r32, (dd * 16 + hi * 8) * 2);
#pragma unroll
    for (int d0 = 0; d0 < 8; ++d0) { const char* a = kb[d0 & 3] + (d0 >> 2) * 128;
        bf16x8 b0 = *reinterpret_cast<const bf16x8*>(a);
        bf16x8 b1 = *reinterpret_cast<const bf16x8*>(a + 32 * 256);
        p0 = __builtin_amdgcn_mfma_f32_32x32x16_bf16(b0, qr[d0], p0, 0, 0, 0);
        p1 = __builtin_amdgcn_mfma_f32_32x32x16_bf16(b1, qr[d0], p1, 0, 0, 0); }
}
template <int VB>
__device__ __forceinline__ void pv_tile(f32x16* o, int vb0, bf16x8 pa0, bf16x8 pa1, bf16x8 pa2, bf16x8 pa3) {
#define TRRD(dst, off) asm volatile("ds_read_b64_tr_b16 %0, %1 offset:%2" : "=&v"(dst) : "v"(vb0), "i"(off) : "memory")
#define PV_D0(d0) do { s16x4 l0, l1, l2, l3, h0, h1, h2, h3; constexpr int b_ = VB * SHM_V + v_rd_off(d0, 0, 0); \
        TRRD(l0, b_); TRRD(h0, b_ + 2048); TRRD(l1, b_ + 4096); TRRD(h1, b_ + 6144); TRRD(l2, b_ + 8192); TRRD(h2, b_ + 10240); TRRD(l3, b_ + 12288); TRRD(h3, b_ + 14336); \
        asm volatile("s_waitcnt lgkmcnt(0)" ::: "memory"); SBAR();   \
        o[d0] = __builtin_amdgcn_mfma_f32_32x32x16_bf16(pa0, (bf16x8){l0[0], l0[1], l0[2], l0[3], h0[0], h0[1], h0[2], h0[3]}, o[d0], 0, 0, 0);   \
        o[d0] = __builtin_amdgcn_mfma_f32_32x32x16_bf16(pa1, (bf16x8){l1[0], l1[1], l1[2], l1[3], h1[0], h1[1], h1[2], h1[3]}, o[d0], 0, 0, 0);   \
        o[d0] = __builtin_amdgcn_mfma_f32_32x32x16_bf16(pa2, (bf16x8){l2[0], l2[1], l2[2], l2[3], h2[0], h2[1], h2[2], h2[3]}, o[d0], 0, 0, 0);   \
        o[d0] = __builtin_amdgcn_mfma_f32_32x32x16_bf16(pa3, (bf16x8){l3[0], l3[1], l3[2], l3[3], h3[0], h3[1], h3[2], h3[3]}, o[d0], 0, 0, 0); } while (0)
    PV_D0(0); PV_D0(1); PV_D0(2); PV_D0(3);
#undef PV_D0
#undef TRRD
}
struct BlockRef { const bf16_t* Q; const bf16_t* K; const bf16_t* V; bf16_t* O; int P0, skv, tab; };
struct Seam { bf16x8 qr[8]; bf16x8 st_v0, st_v1, st_k0, st_k1; };
__device__ __forceinline__ int blk_jhi(const BlockRef& b) { int j = (b.P0 + QB - 1) / KVBLK + 1; const int mx = b.skv / KVBLK; return j > mx ? mx : j; }
template <int MODE> __device__ __forceinline__ int first_kb(const BlockRef& b) { return MODE == 0 ? (blk_jhi(b) - 1) * KVBLK : 0; }
#define ROW(p, k0, rr) ((p) + (size_t)((k0) + (rr)) * HD + sc)
#define VMW() asm volatile("s_waitcnt vmcnt(0)" ::: "memory")
#define VMWN(n) asm volatile("s_waitcnt vmcnt(%0)" :: "i"(n) : "memory")
#define SLOAD_H(Kp, Vp, k0) do { S.st_v0 = load8(ROW(Vp, k0, sr)); S.st_v1 = load8(ROW(Vp, k0, 32 + sr)); S.st_k0 = load8(ROW(Kp, k0, sr)); S.st_k1 = load8(ROW(Kp, k0, 32 + sr)); } while (0)
#define SWRITE_HK(bf) do { *(bf16x8*)(K_lds + (bf) * SHM_K + kws) = S.st_k0; *(bf16x8*)(K_lds + (bf) * SHM_K + kws + 32 * 256) = S.st_k1; } while (0)
#define SWRITE_HV(bf) do { *(bf16x8*)(V_lds + (bf) * SHM_V + vst0) = S.st_v0; *(bf16x8*)(V_lds + (bf) * SHM_V + vst1) = S.st_v1; } while (0)
#define SWRITE_H(bf) do { SWRITE_HV(bf); SWRITE_HK(bf); } while (0)
template <int MODE>
__device__ __forceinline__ void attn_prime(const BlockRef& cur, char* lds, Seam& S) {
    const int tid = opaque_tid(), wid = __builtin_amdgcn_readfirstlane(tid >> 6), lane = tid & 63, r32 = lane & 31, hi = lane >> 5;
    const int sr = tid >> 4, sc = (tid & 15) * 8, kws = KSWZ(sr, sc * 2); char* K_lds = lds + 2 * SHM_V;
    const int kb0 = first_kb<MODE>(cur);
#pragma unroll
    for (int d0 = 0; d0 < 8; ++d0) S.qr[d0] = load8(cur.Q + (size_t)(wid * QBLK + r32) * HD + d0 * 16 + hi * 8);
    SLOAD_H(cur.K, cur.V, kb0); VMW(); SWRITE_HK(0);
    __syncthreads();
}
template <int MODE>
__device__ __forceinline__ void attn_block(const BlockRef& cur, const BlockRef& nxt, char* lds, Seam& S) {
    const int tid = opaque_tid(), wid = __builtin_amdgcn_readfirstlane(tid >> 6), lane = tid & 63, r32 = lane & 31, hi = lane >> 5;
    const int j_hi = blk_jhi(cur), NT = j_hi;
    const int kbn = first_kb<MODE>(nxt);
    const int qlo = cur.P0 + wid * QBLK, qm = qlo + r32 - 4 * hi;
    char* V_lds = lds; char* K_lds = lds + 2 * SHM_V;
    float* wsf = (float*)(lds + WS_OFF) + wid * 64; float* li_l = wsf, * al_l = wsf + 32;
    const float* tabp = (const float*)(lds + cur.tab) + 4 * hi;
    float m_reg = -1e30f, l_reg = 0.f, Rrun = 1.f, tot = 1.f; float E[8]; f32x16 o[4] = {};
    const int sr = tid >> 4, sc = (tid & 15) * 8, vst0 = v_st(sr, sc), vst1 = v_st(32 + sr, sc), kws = KSWZ(sr, sc * 2);
    const int vb0 = (int)(uintptr_t)V_lds + v_rd_base(lane);
    const bf16_t* Kh = cur.K; const bf16_t* Vh = cur.V;
#define RESC(a) do { if (MODE == 1) { if (__any((a) < 1.f)) { if (hi == 0) al_l[r32] = (a); asm volatile("s_waitcnt lgkmcnt(0)" ::: "memory");              \
                     for (int d_ = 0; d_ < 4; ++d_) for (int r = 0; r < 16; ++r) o[d_][r] *= al_l[crow(r, hi)]; } } } while (0)
#define KBASE(t) ((MODE == 0 ? (j_hi - 1 - (t)) : (t)) * KVBLK)
#define MASKT(P0_, P1_, t) do { const int kb_ = KBASE(t); if (MODE == 0) { if (kb_ + KVBLK - 1 >= qlo) mask_tile(P0_, P1_, qm - kb_ - 1, 0x7fffffffu); } \
                                else { if (kb_ + KVBLK - 1 > qlo) mask_tile(P0_, P1_, qm - kb_, 0x7fffffffu); } } while (0)
#define PARTIAL(PX0, PX1, mnX, alX) do { if (MODE == 0) partialSB(PX0, PX1, E, tot, hi); else partialSM(PX0, PX1, m_reg, mnX, alX); } while (0)
#define FINISH(PY0, PY1, alY) do { if (MODE == 0) finishSB(PY0, PY1, E, tot, Rrun, pa0, pa1, pa2, pa3); else finishSM(PY0, PY1, alY, l_reg, pa0, pa1, pa2, pa3); } while (0)
    constexpr int NQL = 8;
#define SEAM_K0() do { VMWN(NQL); SWRITE_HK(0); SBAR(); } while (0)
    f32x16 pA0, pA1, pB0, pB1; float mnA = 0.f, mnB = 0.f, alA = 1.f, alB = 1.f; bf16x8 pa0, pa1, pa2, pa3;
    SWRITE_HV(0); SBAR();
    if (NT > 1) SLOAD_H(Kh, Vh, KBASE(1));
    SBAR(); qkt<0, MODE>(pA0, pA1, K_lds, r32, hi, S.qr, tabp + KBASE(0));
    MASKT(pA0, pA1, 0); PARTIAL(pA0, pA1, mnA, alA);
    if (NT > 1) { VMW(); SWRITE_H(1); }
    __syncthreads();
#define HALF_STEP(PX0, PX1, mnX, alX, PY0, PY1, alY, t, KB, VB, SB) do {                                                      \
        SBAR(); qkt<KB, MODE>(PX0, PX1, K_lds, r32, hi, S.qr, tabp + KBASE(t));                                              \
        FINISH(PY0, PY1, alY); SBAR();                                                                                        \
        if ((t) + 1 < NT) { SLOAD_H(Kh, Vh, KBASE((t) + 1)); SBAR(); }                                                        \
        pv_tile<VB>(o, vb0, pa0, pa1, pa2, pa3); MASKT(PX0, PX1, (t)); PARTIAL(PX0, PX1, mnX, alX);                           \
        __syncthreads();                                                                                                      \
        if ((t) + 1 < NT) { VMW(); SWRITE_H(SB); }                                                                            \
        RESC(alX); __syncthreads(); } while (0)
    for (int t = 1; t + 1 < NT; t += 2) {
        HALF_STEP(pB0, pB1, mnB, alB, pA0, pA1, alA, t, 1, 0, 0);
        HALF_STEP(pA0, pA1, mnA, alA, pB0, pB1, alB, t + 1, 0, 1, 1);
    }
    const bool even = (NT & 1) == 0;
    if (even) { SBAR(); qkt<1, MODE>(pB0, pB1, K_lds, r32, hi, S.qr, tabp + KBASE(NT - 1)); SBAR(); }
    SLOAD_H(nxt.K, nxt.V, kbn); SBAR();
#pragma unroll
    for (int d0 = 0; d0 < 8; ++d0) S.qr[d0] = load8(nxt.Q + (size_t)(wid * QBLK + r32) * HD + d0 * 16 + hi * 8);
    SBAR();
    FINISH(pA0, pA1, alA); SBAR();
    pv_tile<0>(o, vb0, pa0, pa1, pa2, pa3);
    if (even) { MASKT(pB0, pB1, NT - 1); PARTIAL(pB0, pB1, mnB, alB); __syncthreads(); RESC(alB);
        FINISH(pB0, pB1, alB); SBAR(); pv_tile<1>(o, vb0, pa0, pa1, pa2, pa3); }
    SBAR(); SEAM_K0();
    float rli[16];
    if (MODE == 1) { if (hi == 0) li_l[r32] = l_reg; asm volatile("s_waitcnt lgkmcnt(0)" ::: "memory");
#pragma unroll
        for (int r = 0; r < 16; ++r) rli[r] = __builtin_amdgcn_rcpf(li_l[crow(r, hi)]); }
    bf16_t* Ow = cur.O + (size_t)(wid * QBLK) * D_;
#pragma unroll
    for (int r = 0; r < 16; ++r) { const int orow = crow(r, hi);
#pragma unroll
        for (int d0 = 0; d0 < 4; ++d0) { const float v = (MODE == 1) ? o[d0][r] * rli[r] : o[d0][r];
            const float vn = __shfl_xor(v, 1);
            if ((r32 & 1) == 0) *(unsigned*)(Ow + (size_t)orow * D_ + d0 * 32 + r32) = cvtpk(v, vn); } }
    __syncthreads();
#undef RESC
#undef KBASE
#undef MASKT
#undef PARTIAL
#undef FINISH
#undef SEAM_K0
#undef HALF_STEP
}
#undef ROW
#undef VMW
#undef VMWN
#undef SLOAD_H
#undef SWRITE_HK
#undef SWRITE_HV
#undef SWRITE_H
__device__ __forceinline__ void fox_table(char* lds, const float* flogh, float bias) {
    const int tid = opaque_tid(), lane = tid & 63, wid = tid >> 6;
    float* tab = (float*)(lds + TAB_OFF); float* wt = (float*)(lds + WS_OFF);
    float p[16]; const f32x4* src = (const f32x4*)(flogh + 16 * tid);
#pragma unroll
    for (int i = 0; i < 4; ++i) { const f32x4 v = src[i];
#pragma unroll
        for (int j = 0; j < 4; ++j) p[4 * i + j] = softplusf(-(v[j] + bias)) * LOG2E; }
#pragma unroll
    for (int i = 1; i < 16; ++i) p[i] += p[i - 1];
    float inc = p[15];
#pragma unroll
    for (int off = 1; off < 64; off <<= 1) { const float v = __shfl_up(inc, off); if (lane >= off) inc += v; }
    if (lane == 63) wt[wid] = inc;
    __syncthreads();
    float base = inc - p[15];
    for (int w2 = 0; w2 < wid; ++w2) base += wt[w2];
#pragma unroll
    for (int i = 0; i < 16; ++i) tab[16 * tid + i] = base + p[i];
    __syncthreads();
}
}

__device__ __forceinline__ void phase_attention(unsigned char* shm, unsigned char* ws, int L, const float* fbias) {
    char* lds = (char*)shm;
    const int tid0 = opaque_tid();
    { float* z = (float*)(lds + at::ZERO_OFF); if (tid0 < 256) z[tid0] = 0.f; }
    __syncthreads();
    const bf16_t* qkv = (const bf16_t*)(ws + WS_QKV); const bf16_t* kvm = (const bf16_t*)(ws + WS_KVMEM); bf16_t* ao = (bf16_t*)(ws + WS_AO);
    for (int v = blockIdx.x; v < 256; v += gridDim.x) {
        const bool mix = v < 192;
        const int head = mix ? (v >> 4) : ((v - 192) >> 4);
        const int q0 = mix ? (v & 15) : (((v - 192) * 2) & 31), q1 = mix ? 31 - q0 : q0 + 1;
        const bf16_t* Qh = qkv + (size_t)(mix ? head : 36 + head) * S_ * HD;
        const bf16_t* Kh = mix ? qkv + (size_t)(12 + head) * S_ * HD : kvm + (size_t)head * NMEM * HD;
        const bf16_t* Vh = mix ? qkv + (size_t)(24 + head) * S_ * HD : kvm + (size_t)(4 + head) * NMEM * HD;
        bf16_t* Oh = ao + (mix ? head : 12 + head) * HD;
        const int skv = mix ? S_ : NMEM, tab = mix ? at::TAB_OFF : at::ZERO_OFF;
#define MKREF(qb) at::BlockRef{Qh + (size_t)(qb) * 256 * HD, Kh, Vh, Oh + (size_t)(qb) * 256 * D_, mix ? (qb) * 256 : NMEM, skv, tab}
        at::Seam S;
        if (L == 0 && mix) {
            at::attn_prime<0>(MKREF(q0), lds, S);
#pragma unroll 1
            for (int i = 0; i < 2; ++i) at::attn_block<0>(MKREF(i ? q1 : q0), MKREF(q1), lds, S);
        } else {
            if (mix) at::fox_table(lds, (const float*)(ws + WS_FLOG) + (size_t)head * S_, fbias[head]);
            at::attn_prime<1>(MKREF(q0), lds, S);
#pragma unroll 1
            for (int i = 0; i < 2; ++i) at::attn_block<1>(MKREF(i ? q1 : q0), MKREF(q1), lds, S);
        }
#undef MKREF
    }
}

struct LayerP { const float *w_in, *fbias, *w_o, *g1, *b1, *router, *rbias, *wgu, *wd, *sgu, *sd, *g2, *b2; };
__host__ __device__ __forceinline__ LayerP layer_params(const float* const* in, int L) {
    LayerP p;
    if (L == 0) { p.w_in = in[5]; p.fbias = nullptr; p.w_o = in[6]; p.g1 = in[7]; p.b1 = in[8]; p.router = in[9]; p.rbias = in[10]; p.wgu = in[11]; p.wd = in[12]; p.sgu = in[13]; p.sd = in[14]; p.g2 = in[15]; p.b2 = in[16]; }
    else { p.w_in = in[17]; p.fbias = in[18]; p.w_o = in[19]; p.g1 = in[20]; p.b1 = in[21]; p.router = in[22]; p.rbias = in[23]; p.wgu = in[24]; p.wd = in[25]; p.sgu = in[26]; p.sd = in[27]; p.g2 = in[28]; p.b2 = in[29]; }
    return p;
}
constexpr int NPH = 15;
#ifndef FAST_MASK
#define FAST_MASK 63
#endif
constexpr int F_PRO = 1, F_INPROJ = 2, F_ATTN = 4, F_OUTPROJ = 8, F_GU = 16, F_DOWN = 32;
constexpr int FAST = FAST_MASK;

__global__ void __launch_bounds__(NWAVES * 64, 2) mega(Args a) {
    extern __shared__ __attribute__((aligned(16))) unsigned char shm[];
    LAS unsigned char* lds = (LAS unsigned char*)shm;
    const int tid = threadIdx.x;
    unsigned char* ws = a.ws;
    volatile LAS unsigned* MISC = (volatile LAS unsigned*)(lds + MISC_OFF);
    if (tid < 64) ((LAS unsigned*)(lds + MISC_OFF))[tid] = 0u;
    __syncthreads();
    const int lo = a.ph_lo, hi = a.ph_hi;
    const bool multi = (hi - lo) > 1;
    XcdBarrier bar; bar.bar = (unsigned*)(ws + WS_CTL) + CW_BAR; bar.x = 0; bar.st = nullptr;
    if (multi) bar = xcd_barrier_post((unsigned*)(ws + WS_CTL) + CW_BAR, MISC + 8);
#define IN(k) (lo <= (k) && (k) < hi)
#define SEAM(k) do { if (IN(k) && IN((k) + 1)) xcd_barrier(bar); } while (0)
    const int G = (int)gridDim.x, bx = (int)blockIdx.x;
    const int vcu = (G % 8 == 0) ? (bx % 8) * (G / 8) + bx / 8 : bx;
    if constexpr ((FAST & (F_PRO | F_INPROJ | F_OUTPROJ | F_GU | F_DOWN)) != 0) { if (IN(0)) phase_prologue(lds, a); }
    SEAM(0);
    for (int L = 0; L < 2; ++L) {
        const LayerP P = layer_params(a.in, L);
        const int pb = 1 + 7 * L;
        if constexpr ((FAST & F_INPROJ) != 0) { if (IN(pb + 0)) {
            pg8::PlainOrder S; S.init((const bf16_t*)(ws + WS_XB), (const bf16_t*)(ws + (L == 0 ? WS_WIN0 : WS_WIN1)), S_, L == 0 ? NQKV0 : NQKV1P, D_, G, bx);
            pg8::EpiHead E{(bf16_t*)(ws + WS_QKV), S_, 40, 1, L == 0 ? nullptr : (float*)(ws + WS_FLOG)};
            pg8::gemm_phase(lds, S, E);
            if (L == 0) { pg8::PlainOrder S2; S2.init((const bf16_t*)(ws + WS_MEMN), (const bf16_t*)(ws + WS_WMEM), NMEM, 1024, D_, G, G - 1 - bx);
                pg8::EpiHead E2{(bf16_t*)(ws + WS_KVMEM), NMEM, 8, 0, nullptr}; pg8::gemm_phase(lds, S2, E2); }
        } }
        SEAM(pb + 0);
        if constexpr ((FAST & F_ATTN) != 0) { if (IN(pb + 1)) phase_attention(shm, ws, L, P.fbias); }
        SEAM(pb + 1);
        if constexpr ((FAST & F_OUTPROJ) != 0) { if (IN(pb + 2)) {
            pg8::PlainOrder S; S.init((const bf16_t*)(ws + WS_AO), (const bf16_t*)(ws + (L == 0 ? WS_WO0 : WS_WO1)), S_, D_, D_, G, bx);
            pg8::EpiT1 E{L == 0 ? a.in[0] : (const float*)(ws + WS_X2F), (float*)(ws + WS_T1)};
            pg8::gemm_phase(lds, S, E);
        } }
        SEAM(pb + 2);
        if (IN(pb + 3)) { phase_ln_router(lds, ws, P.g1, P.b1, P.router, P.rbias, L); }
        SEAM(pb + 3);
        if constexpr ((FAST & F_GU) != 0) { if (IN(pb + 4)) {
            build_prefix(lds, (const unsigned*)(ws + WS_CTL) + CW_CNT + 64 * L);
            pg8::GroupedOrder<true> S{(const bf16_t*)(ws + WS_X1B), (const bf16_t*)(ws + (L == 0 ? WS_WGU0 : WS_WGU1)), D_, 1024, 4, G, vcu,
                (const LAS int*)(lds + LDSCTL_OFF + 512), (const LAS int*)(lds + LDSCTL_OFF), (const int*)(ws + WS_LIST)};
            pg8::EpiGU E{(bf16_t*)(ws + WS_H)};
            pg8::gemm_phase(lds, S, E);
        } }
        SEAM(pb + 4);
        if constexpr ((FAST & F_DOWN) != 0) { if (IN(pb + 5)) {
            build_prefix(lds, (const unsigned*)(ws + WS_CTL) + CW_CNT + 64 * L);
            pg8::GroupedOrder<false> S{(const bf16_t*)(ws + WS_H), (const bf16_t*)(ws + (L == 0 ? WS_WD0 : WS_WD1)), EFF, D_, 8, G, vcu,
                (const LAS int*)(lds + LDSCTL_OFF + 512), (const LAS int*)(lds + LDSCTL_OFF), (const int*)(ws + WS_LIST)};
            pg8::EpiDown E{(bf16_t*)(ws + WS_Y), (const float*)(ws + WS_ROWW)};
            pg8::gemm_phase(lds, S, E);
        } }
        SEAM(pb + 5);
        if (IN(pb + 6)) { phase_combine(lds, ws, P.g2, P.b2, L == 0 ? (float*)(ws + WS_X2F) : a.out, L == 0 ? (bf16_t*)(ws + WS_XB) : nullptr, L); }
        SEAM(pb + 6);
    }
#undef IN
#undef SEAM
}

extern "C" void kernel_launch(void* const* d_in, const int* in_sizes, int n_in, void* d_out, int out_size, void* d_ws, size_t ws_size, hipStream_t stream) {
    static int grid = 0;
    if (grid == 0) {
        if (n_in != 30 || out_size != S_ * D_ || ws_size < WS_END) { fprintf(stderr, "kernel_launch: unexpected shapes n_in %d out %d ws %zu\n", n_in, out_size, ws_size); grid = -1; return; }
        if (hipFuncSetAttribute((const void*)mega, hipFuncAttributeMaxDynamicSharedMemorySize, LDS_BYTES) != hipSuccess) { fprintf(stderr, "hipFuncSetAttribute failed\n"); grid = -1; return; }
        int dev = 0, cus = 0, per_cu = 0; (void)hipGetDevice(&dev); (void)hipDeviceGetAttribute(&cus, hipDeviceAttributeMultiprocessorCount, dev);
        (void)hipOccupancyMaxActiveBlocksPerMultiprocessor(&per_cu, (const void*)mega, NWAVES * 64, LDS_BYTES);
        (void)hipGetLastError();
        grid = (cus > 0 && per_cu >= 1) ? cus : 256; if (grid > 256) grid = 256;
    }
    if (grid < 0) return;
    unsigned char* ws = (unsigned char*)d_ws;
    (void)hipMemsetAsync(ws + WS_CTL, 0, CTL_ZERO_BYTES, stream);
    Args a{};
    for (int i = 0; i < 30; ++i) a.in[i] = (const float*)d_in[i];
    a.out = (float*)d_out; a.ws = ws;
    auto run_mega = [&](int lo, int hi) { a.ph_lo = lo; a.ph_hi = hi; hipLaunchKernelGGL(mega, dim3(grid), dim3(NWAVES * 64), LDS_BYTES, stream, a); };
    if (FAST == 63) { run_mega(0, NPH); return; }
    const bool any_fast_gemm = (FAST & (F_INPROJ | F_OUTPROJ | F_GU | F_DOWN)) != 0;
    if ((FAST & F_PRO) || any_fast_gemm) run_mega(0, 1);
    else hipLaunchKernelGGL(slow_prep, dim3(1024), dim3(256), 0, stream, a.in[0], a.in[1], a.in[2], a.in[3], (bf16_t*)(ws + WS_XB), (bf16_t*)(ws + WS_MEMN));
    for (int L = 0; L < 2; ++L) {
        const LayerP P = layer_params(a.in, L); const int pb = 1 + 7 * L;
        const float* xf = (L == 0) ? a.in[0] : (const float*)(ws + WS_X2F);
        if (FAST & F_INPROJ) run_mega(pb + 0, pb + 1);
        else {
            SlowP p{}; p.A = (const bf16_t*)(ws + WS_XB); p.W = P.w_in; p.K = D_; p.ldw = (L == 0) ? NQKV0 : NQKV1; p.N = p.ldw; p.M = S_; p.L = L; p.ws = ws;
            hipLaunchKernelGGL(slow_gemm<0>, dim3((p.N + 63) / 64, S_ / 64), dim3(256), 0, stream, p);
            if (L == 0) { SlowP q{}; q.A = (const bf16_t*)(ws + WS_MEMN); q.W = a.in[4]; q.K = D_; q.ldw = 1024; q.N = 1024; q.M = NMEM; q.ws = ws;
                hipLaunchKernelGGL(slow_gemm<2>, dim3(16, NMEM / 64), dim3(256), 0, stream, q); }
        }
        if (FAST & F_ATTN) run_mega(pb + 1, pb + 2);
        else {
            const bf16_t* qkv = (const bf16_t*)(ws + WS_QKV); const bf16_t* kvm = (const bf16_t*)(ws + WS_KVMEM); float* cfn = (float*)(ws + WS_CFN); bf16_t* ao = (bf16_t*)(ws + WS_AO);
            if (L == 0) hipLaunchKernelGGL(slow_attn<0>, dim3(NH * S_ / 4), dim3(256), 0, stream, qkv, kvm, (const float*)cfn, ao);
            else { hipLaunchKernelGGL(slow_scan, dim3(1), dim3(64), 0, stream, (const float*)(ws + WS_FLOG), P.fbias, cfn);
                   hipLaunchKernelGGL(slow_attn<1>, dim3(NH * S_ / 4), dim3(256), 0, stream, qkv, kvm, (const float*)cfn, ao); }
            hipLaunchKernelGGL(slow_attn<2>, dim3(NMH * S_ / 4), dim3(256), 0, stream, qkv, kvm, (const float*)cfn, ao);
        }
        if (FAST & F_OUTPROJ) run_mega(pb + 2, pb + 3);
        else { SlowP p{}; p.A = (const bf16_t*)(ws + WS_AO); p.W = P.w_o; p.K = D_; p.ldw = D_; p.N = D_; p.M = S_; p.L = L; p.ws = ws; p.xf = xf;
            hipLaunchKernelGGL(slow_gemm<1>, dim3(D_ / 64, S_ / 64), dim3(256), 0, stream, p); }
        run_mega(pb + 3, pb + 4);
        if (FAST & F_GU) run_mega(pb + 4, pb + 5);
        else { SlowP p{}; p.A = (const bf16_t*)(ws + WS_X1B); p.W = P.wgu; p.W2 = P.sgu; p.K = D_; p.ldw = 2 * EFF; p.N = EFF; p.M = MAXROWS; p.L = L; p.ws = ws;
            hipLaunchKernelGGL(slow_gemm<3>, dim3(EFF / 64, MAXROWS / 64), dim3(256), 0, stream, p); }
        if (FAST & F_DOWN) run_mega(pb + 5, pb + 6);
        else { SlowP p{}; p.A = (const bf16_t*)(ws + WS_H); p.W = P.wd; p.W2 = P.sd; p.K = EFF; p.ldw = D_; p.N = D_; p.M = MAXROWS; p.L = L; p.ws = ws;
            hipLaunchKernelGGL(slow_gemm<4>, dim3(D_ / 64, MAXROWS / 64), dim3(256), 0, stream, p); }
        run_mega(pb + 6, pb + 7);
    }
}
```

```cpp
#include <hip/hip_runtime.h>
#include <cstdio>
#include <cstdint>

#define LAS __attribute__((address_space(3)))
#define GAS __attribute__((address_space(1)))
typedef unsigned short bf16_t;
typedef short bf16x8 __attribute__((ext_vector_type(8)));
typedef short s16x4 __attribute__((ext_vector_type(4)));
typedef float f32x2 __attribute__((ext_vector_type(2)));
typedef float f32x4 __attribute__((ext_vector_type(4)));
typedef float f32x16 __attribute__((ext_vector_type(16)));
typedef unsigned u32x2 __attribute__((ext_vector_type(2)));
typedef unsigned u32x4 __attribute__((ext_vector_type(4)));

constexpr int S_ = 8192, D_ = 2048, HD = 128, NH = 12, NMH = 4, NMEM = 256, NE = 64, TOPK = 8, EFF = 512;
constexpr int NQKV0 = 5120, NQKV1 = 5132, NQKV1P = 5376;
constexpr float ALPHA = 1.4142135623730951f, LN_EPS = 1e-5f, LOG2E = 1.4426950408889634f, LN2 = 0.6931471805599453f;
constexpr float QSCALE = 0.08838834764831845f * 1.4426950408889634f;
constexpr int MAXTILES = 352, MAXROWS = MAXTILES * 256;

constexpr size_t MiB = 1u << 20;
constexpr size_t WS_CTL = 0, CTL_ZERO_BYTES = 1 * MiB;
constexpr size_t WS_WIN0 = 1 * MiB, WS_WIN1 = 21 * MiB, WS_WO0 = 42 * MiB, WS_WO1 = 50 * MiB, WS_WMEM = 58 * MiB;
constexpr size_t WS_WGU0 = 62 * MiB, WS_WGU1 = 322 * MiB, WS_WD0 = 582 * MiB, WS_WD1 = 712 * MiB;
constexpr size_t WS_XB = 842 * MiB, WS_X2F = 874 * MiB, WS_QKV = 938 * MiB, WS_FLOG = 1018 * MiB, WS_KVMEM = 1019 * MiB, WS_MEMN = 1020 * MiB;
constexpr size_t WS_AO = 1021 * MiB, WS_T1 = 1053 * MiB, WS_X1F = 1117 * MiB, WS_X1B = 1181 * MiB;
constexpr size_t WS_TKE = 1213 * MiB, WS_TKW = WS_TKE + 256 * 1024, WS_TKP = WS_TKE + 512 * 1024, WS_LIST = 1214 * MiB, WS_ROWW = 1216 * MiB;
constexpr size_t WS_H = 1218 * MiB, WS_Y = 1306 * MiB, WS_CFN = 1658 * MiB, WS_END = 1659 * MiB;
constexpr int CW_BAR = 4096, CW_CNT = 16384;

__device__ __forceinline__ unsigned cvtpk(float lo, float hi) { unsigned r; asm volatile("v_cvt_pk_bf16_f32 %0, %1, %2" : "=v"(r) : "v"(lo), "v"(hi)); return r; }
__device__ __forceinline__ float bf2f(bf16_t b) { return __uint_as_float(((unsigned)b) << 16); }
__device__ __forceinline__ bf16_t f2bf(float f) { return (bf16_t)(cvtpk(f, 0.f) & 0xffffu); }
__device__ __forceinline__ int crow(int r, int hi) { return (r & 3) + 8 * (r >> 2) + 4 * hi; }
__device__ __forceinline__ float wave_sum(float v) {
#pragma unroll
    for (int o = 1; o < 64; o <<= 1) v += __shfl_xor(v, o);
    return v;
}
__device__ __forceinline__ float wave_max(float v) {
#pragma unroll
    for (int o = 1; o < 64; o <<= 1) v = fmaxf(v, __shfl_xor(v, o));
    return v;
}
__device__ __forceinline__ float softplusf(float z) { return fmaxf(z, 0.f) + log1pf(expf(-fabsf(z))); }

__device__ __forceinline__ int opaque_tid() { int t = (int)threadIdx.x; asm volatile("" : "+v"(t)); return t; }
struct Args { const float* in[30]; float* out; unsigned char* ws; int ph_lo, ph_hi, rep, pad; };

__device__ __forceinline__ void slow_prefix(const unsigned* gcnt, int* cntl, int* tp) {
    if (threadIdx.x < 64) cntl[threadIdx.x] = (int)gcnt[threadIdx.x];
    if (threadIdx.x == 64) cntl[64] = S_;
    __syncthreads();
    if (threadIdx.x == 0) { int a = 0; for (int e = 0; e < 65; ++e) { tp[e] = a; a += (cntl[e] + 255) >> 8; } tp[65] = a; }
    __syncthreads();
}
struct SlowP { const bf16_t* A; const float* W; int K, ldw, N, M; int L, pad; unsigned char* ws; const float* xf; const float* W2; };
template <int MODE> __global__ __launch_bounds__(256) void slow_gemm(SlowP p) {
    __shared__ int cntl[65]; __shared__ int tp[66];
    const int wave = threadIdx.x >> 6, lane = threadIdx.x & 63, r = lane & 31, hi = lane >> 5, wm = wave >> 1, wn = wave & 1;
    const int n0 = blockIdx.x * 64 + wn * 32; int m0 = blockIdx.y * 64 + wm * 32;
    const bf16_t* arow; const float* W = p.W; int e = 0, cnt = 0, lbase = 0;
    if (MODE >= 3) {
        slow_prefix((const unsigned*)(p.ws + WS_CTL) + CW_CNT + 64 * p.L, cntl, tp);
        const int tile = (blockIdx.y * 64) >> 8; if (tile >= tp[65]) return;
        while (tp[e + 1] <= tile) ++e;
        cnt = cntl[e]; lbase = (tile - tp[e]) * 256 + ((blockIdx.y * 64) & 255) + wm * 32;
        if (MODE == 3) { const int lr = lbase + r; int tok = 0; if (lr < cnt) tok = (e < 64) ? ((const int*)(p.ws + WS_LIST))[e * S_ + lr] : lr; arow = p.A + (size_t)tok * p.K;
            W = (e < 64) ? p.W + (size_t)e * D_ * 1024 : p.W2; }
        else { arow = p.A + (size_t)(m0 + r) * p.K; W = (e < 64) ? p.W + (size_t)e * EFF * D_ : p.W2; }
    } else arow = p.A + (size_t)(m0 + r) * p.K;
    const int col = n0 + r; const bool cok = col < p.N;
    f32x16 acc = {}, acc2 = {};
    for (int k0 = 0; k0 < p.K; k0 += 16) {
        const bf16x8 a = *(const bf16x8*)(arow + k0 + 8 * hi);
        float bv[8], bu[8];
#pragma unroll
        for (int j = 0; j < 8; ++j) { bv[j] = cok ? W[(size_t)(k0 + 8 * hi + j) * p.ldw + col] : 0.f; if (MODE == 3) bu[j] = W[(size_t)(k0 + 8 * hi + j) * p.ldw + col + EFF]; }
        u32x4 bw = {cvtpk(bv[0], bv[1]), cvtpk(bv[2], bv[3]), cvtpk(bv[4], bv[5]), cvtpk(bv[6], bv[7])};
        acc = __builtin_amdgcn_mfma_f32_32x32x16_bf16(a, *(bf16x8*)&bw, acc, 0, 0, 0);
        if (MODE == 3) { u32x4 bw2 = {cvtpk(bu[0], bu[1]), cvtpk(bu[2], bu[3]), cvtpk(bu[4], bu[5]), cvtpk(bu[6], bu[7])};
            acc2 = __builtin_amdgcn_mfma_f32_32x32x16_bf16(a, *(bf16x8*)&bw2, acc2, 0, 0, 0); }
    }
    if (!cok) return;
#pragma unroll
    for (int g = 0; g < 16; ++g) {
        const int row = m0 + crow(g, hi); const float v = acc[g];
        if (MODE == 0) {
            if (col < 5120) { const int head = col >> 7; const float sc = (head < 12 || head >= 36) ? QSCALE : 1.f;
                ((bf16_t*)(p.ws + WS_QKV))[((size_t)head * S_ + row) * HD + (col & 127)] = f2bf(v * sc); }
            else ((float*)(p.ws + WS_FLOG))[(size_t)(col - 5120) * S_ + row] = v;
        } else if (MODE == 1) {
            ((float*)(p.ws + WS_T1))[(size_t)row * D_ + col] = ALPHA * p.xf[(size_t)row * D_ + col] + v;
        } else if (MODE == 2) {
            ((bf16_t*)(p.ws + WS_KVMEM))[((size_t)(col >> 7) * NMEM + row) * HD + (col & 127)] = f2bf(v);
        } else if (MODE == 3) {
            const float u = acc2[g]; const float hv = v / (1.f + expf(-v)) * u;
            ((bf16_t*)(p.ws + WS_H))[(size_t)row * EFF + col] = f2bf(hv);
        } else {
            const int lr = lbase + crow(g, hi); float gate = 0.f; if (lr < cnt) gate = (e < 64) ? ((const float*)(p.ws + WS_ROWW))[e * S_ + lr] : 1.f;
            ((bf16_t*)(p.ws + WS_Y))[(size_t)row * D_ + col] = f2bf(v * gate);
        }
    }
}
__global__ void slow_scan(const float* flog, const float* fbias, float* cfn) {
    const int h = threadIdx.x; if (h >= NH) return;
    float a = 0.f; const float b = fbias[h];
    for (int t = 0; t < S_; ++t) { a += -softplusf(-(flog[(size_t)h * S_ + t] + b)); cfn[(size_t)h * S_ + t] = a; }
}
template <int MODE> __global__ __launch_bounds__(256) void slow_attn(const bf16_t* qkv, const bf16_t* kvmem, const float* cfn, bf16_t* ao) {
    __shared__ float qs[4][HD];
    const int wave = threadIdx.x >> 6, lane = threadIdx.x & 63;
    const int gw = blockIdx.x * 4 + wave, head = gw / S_, t = gw % S_;
    const int qh = (MODE == 2) ? 36 + head : head;
    const bf16_t* q = qkv + ((size_t)qh * S_ + t) * HD;
    const bf16_t* K = (MODE == 2) ? kvmem + (size_t)head * NMEM * HD : qkv + (size_t)(12 + head) * S_ * HD;
    const bf16_t* V = (MODE == 2) ? kvmem + (size_t)(4 + head) * NMEM * HD : qkv + (size_t)(24 + head) * S_ * HD;
    qs[wave][lane] = bf2f(q[lane]) * LN2; qs[wave][lane + 64] = bf2f(q[lane + 64]) * LN2;
    __syncthreads();
    const int nkeys = (MODE == 0) ? t : (MODE == 1 ? t + 1 : NMEM);
    const int nch = (nkeys + 63) >> 6;
    float o0 = 0.f, o1 = 0.f, carry = 0.f, mrun = -__builtin_inff(), lrun = 0.f;
    const float cft = (MODE == 1) ? cfn[(size_t)head * S_ + t] : 0.f;
    for (int ci = 0; ci < nch; ++ci) {
        const int c = (MODE == 0) ? nch - 1 - ci : ci; const int base = c * 64, key = base + lane; const bool valid = key < nkeys;
        float z = 0.f;
        if (valid) { const bf16_t* kr = K + (size_t)key * HD;
            for (int d8 = 0; d8 < 16; ++d8) { const bf16x8 kv = *(const bf16x8*)(kr + d8 * 8);
#pragma unroll
                for (int j = 0; j < 8; ++j) z += qs[wave][d8 * 8 + j] * bf2f((bf16_t)kv[j]); } }
        float w;
        if (MODE == 0) {
            const float ls = valid ? -softplusf(z) : 0.f; float s = ls;
#pragma unroll
            for (int off = 1; off < 64; off <<= 1) { const float v = __shfl_down(s, off); if (lane + off < 64) s += v; }
            const float la = s - ls + carry; w = valid ? expf(z + ls + la) : 0.f; carry += __shfl(s, 0);
        } else {
            float lg = valid ? z : -__builtin_inff(); if (MODE == 1 && valid) lg += cft - cfn[(size_t)head * S_ + key];
            const float mc = wave_max(lg), mn = fmaxf(mrun, mc), al = expf(mrun - mn);
            w = valid ? expf(lg - mn) : 0.f; lrun = lrun * al + wave_sum(w); o0 *= al; o1 *= al; mrun = mn;
        }
        for (int j = 0; j < 64; ++j) { if (base + j >= nkeys) break; const float wj = __shfl(w, j);
            const unsigned vv = *(const unsigned*)(V + (size_t)(base + j) * HD + 2 * lane);
            o0 += wj * __uint_as_float(vv << 16); o1 += wj * __uint_as_float(vv & 0xffff0000u); }
    }
    if (MODE != 0) { const float il = 1.f / lrun; o0 *= il; o1 *= il; }
    const int ocol = ((MODE == 2) ? 12 + head : head) * HD + 2 * lane;
    *(unsigned*)(ao + (size_t)t * D_ + ocol) = cvtpk(o0, o1);
}
__global__ __launch_bounds__(256) void slow_prep(const float* x, const float* mem, const float* g, const float* b, bf16_t* xb, bf16_t* memn) {
    const size_t n = (size_t)S_ * D_;
    for (size_t i = (size_t)blockIdx.x * 256 + threadIdx.x; i < n; i += (size_t)gridDim.x * 256) xb[i] = f2bf(x[i]);
    const int wave = threadIdx.x >> 6, lane = threadIdx.x & 63, gw = blockIdx.x * 4 + wave;
    if (gw < NMEM) { const float* row = mem + (size_t)gw * D_; float s = 0.f; for (int i = lane; i < D_; i += 64) s += row[i]; const float mean = wave_sum(s) / D_;
        float q = 0.f; for (int i = lane; i < D_; i += 64) { const float d = row[i] - mean; q += d * d; } const float rstd = 1.f / sqrtf(wave_sum(q) / D_ + LN_EPS);
        for (int i = lane; i < D_; i += 64) memn[(size_t)gw * D_ + i] = f2bf((row[i] - mean) * rstd * g[i] + b[i]); }
}

constexpr int NWAVES = 8;
constexpr int RING_BYTES = 131072, LDSCTL_OFF = RING_BYTES, TEXP_OFF = LDSCTL_OFF + 1024, MISC_OFF = LDSCTL_OFF + 2560;
constexpr int LDS_BYTES = 147456;
#define RLX_AGENT __ATOMIC_RELAXED, __HIP_MEMORY_SCOPE_AGENT
#define LDS_WAIT() asm volatile("s_waitcnt lgkmcnt(0)" ::: "memory")
#define VM_WAIT() asm volatile("s_waitcnt vmcnt(0)" ::: "memory")

#define XB_TMO      128
#define XB_XCNT(j)  (256  + 64 * (j))
#define XB_XSUB(j)  (1280 + 64 * (j))
#define XB_XGEN(j)  (2304 + 64 * (j))
#define XB_TOP      3328
#define XB_TOPGEN   3392
#define XCD_BAR_WORDS 3456
#define XB_SPIN_CAP (1u << 18)
__device__ __forceinline__ unsigned xb_ld(unsigned* p)              { return __hip_atomic_load(p, __ATOMIC_RELAXED, __HIP_MEMORY_SCOPE_AGENT); }
__device__ __forceinline__ unsigned xb_add(unsigned* p, unsigned v) { return __hip_atomic_fetch_add(p, v, __ATOMIC_RELAXED, __HIP_MEMORY_SCOPE_AGENT); }
__device__ __forceinline__ unsigned xb_xcc_id() { return (unsigned)__builtin_amdgcn_s_getreg((3 << 11) | 20) & 0xFu; }
#define XB_SPIN(cond, bar) do { unsigned _sp = 0; while (cond) { __builtin_amdgcn_s_sleep(1); \
    if ((++_sp & 255u) == 0u) { if (xb_ld(&(bar)[XB_TMO])) break; if (_sp > XB_SPIN_CAP) { atomicAdd(&(bar)[XB_TMO], 1u); break; } } } } while (0)
struct XcdBarrier { unsigned* bar; unsigned x; volatile LAS unsigned* st; };
__device__ __forceinline__ XcdBarrier xcd_barrier_post(unsigned* bar, volatile LAS unsigned* st) {
    XcdBarrier b; b.bar = bar; b.x = xb_xcc_id(); b.st = st;
    if (threadIdx.x == 0) (void)xb_add(&bar[XB_XCNT(b.x)], 1u);
    return b;
}
__device__ __forceinline__ void xcd_barrier_complete(unsigned* bar, unsigned x, unsigned& nloc, unsigned& nx) {
    const unsigned G = gridDim.x * gridDim.y * gridDim.z;
    unsigned sum, cnt, mine, sp = 0u;
    for (;;) {
        sum = 0u; cnt = 0u; mine = 0u;
#pragma unroll
        for (unsigned j = 0; j < 16; ++j) { const unsigned c = xb_ld(&bar[XB_XCNT(j)]); sum += c; cnt += (c > 0u) ? 1u : 0u; mine = (j == x) ? c : mine; }
        if (sum == G) break;
        __builtin_amdgcn_s_sleep(1);
        if ((++sp & 255u) == 0u) { if (xb_ld(&bar[XB_TMO])) break; if (sp > XB_SPIN_CAP) { atomicAdd(&bar[XB_TMO], 1u); break; } }
    }
    nloc = mine > 0u ? mine : 1u; nx = cnt > 0u ? cnt : 1u;
}
__device__ __forceinline__ void xcd_barrier(const XcdBarrier& b) {
    asm volatile("s_waitcnt vmcnt(0)" ::: "memory");
    __syncthreads();
    if (threadIdx.x == 0) {
        unsigned* bar = b.bar;
        __builtin_amdgcn_s_waitcnt(0);
        unsigned nloc = b.st[0], nx = b.st[1];
        if (nloc == 0u) { xcd_barrier_complete(bar, b.x, nloc, nx); b.st[0] = nloc; b.st[1] = nx; }
        const unsigned old = xb_add(&bar[XB_XSUB(b.x)], 1u);
        const unsigned gen = old / nloc;
        if (old + 1u == (gen + 1u) * nloc) {
            __builtin_amdgcn_fence(__ATOMIC_RELEASE, "agent");
            asm volatile("s_waitcnt vmcnt(0)" ::: "memory");
            const unsigned og = xb_add(&bar[XB_TOP], 1u);
            const unsigned tg = og / nx;
            if (og + 1u == (tg + 1u) * nx) xb_add(&bar[XB_TOPGEN], 1u);
            else XB_SPIN(xb_ld(&bar[XB_TOPGEN]) == tg, bar);
            __builtin_amdgcn_fence(__ATOMIC_ACQUIRE, "agent");
            xb_add(&bar[XB_XGEN(b.x)], 1u);
            asm volatile("s_waitcnt vmcnt(0)" ::: "memory");
        } else {
            XB_SPIN(xb_ld(&bar[XB_XGEN(b.x)]) == gen, bar);
            __builtin_amdgcn_fence(__ATOMIC_ACQUIRE, "agent");
            asm volatile("s_waitcnt vmcnt(0)" ::: "memory");
        }
    }
    __syncthreads();
}

__device__ __forceinline__ void build_prefix(LAS unsigned char* lds, const unsigned* gcnt) {
    LAS int* cntl = (LAS int*)(lds + LDSCTL_OFF); LAS int* tp = (LAS int*)(lds + LDSCTL_OFF + 512);
    const int tid = opaque_tid();
    if (tid < 64) cntl[tid] = (int)__hip_atomic_load(gcnt + tid, RLX_AGENT);
    if (tid == 64) cntl[64] = S_;
    __syncthreads();
    if (tid == 0) { int a = 0; for (int e = 0; e < 65; ++e) { tp[e] = a; a += (cntl[e] + 255) >> 8; } tp[65] = a; }
    __syncthreads();
    if (tid < 65) { LAS unsigned char* texp = lds + TEXP_OFF; for (int t = tp[tid]; t < tp[tid + 1]; ++t) texp[t] = (unsigned char)tid; }
    __syncthreads();
}

__device__ __forceinline__ void phase_ln_router(LAS unsigned char* lds, unsigned char* ws, const float* g, const float* b, const float* Wr, const float* rbias, int L) {
    const int tid = opaque_tid(), lane = tid & 63, w = __builtin_amdgcn_readfirstlane(tid >> 6), r32 = lane & 31, hi = lane >> 5;
    const float* t1 = (const float*)(ws + WS_T1); float* x1f = (float*)(ws + WS_X1F); bf16_t* x1b = (bf16_t*)(ws + WS_X1B);
    int* tke = (int*)(ws + WS_TKE); int* tkp = (int*)(ws + WS_TKP); int* list = (int*)(ws + WS_LIST); float* roww = (float*)(ws + WS_ROWW);
    unsigned* gcnt = (unsigned*)(ws + WS_CTL) + CW_CNT + 64 * L;
    LAS float* part = (LAS float*)lds; LAS float* logits = (LAS float*)(lds + 65536);
    LAS int* lcnt = (LAS int*)(lds + 73728); LAS int* gbase = (LAS int*)(lds + 73728 + 256);
    LAS int* ent_e = (LAS int*)(lds + 74240); LAS float* ent_w = (LAS float*)(lds + 74240 + 1024); LAS int* ent_r = (LAS int*)(lds + 74240 + 2048);
    for (int rg = blockIdx.x; rg < S_ / 32; rg += gridDim.x) {
        if (tid < 64) lcnt[tid] = 0;
#pragma unroll 1
        for (int i = 0; i < 4; ++i) {
            const size_t row = (size_t)rg * 32 + w * 4 + i;
            const f32x4* tr = (const f32x4*)(t1 + row * D_) + lane; f32x4 v[8]; float s = 0.f;
#pragma unroll
            for (int j = 0; j < 8; ++j) { v[j] = tr[64 * j]; s += (v[j][0] + v[j][1]) + (v[j][2] + v[j][3]); }
            const float mean = wave_sum(s) * (1.f / D_); float q = 0.f;
#pragma unroll
            for (int j = 0; j < 8; ++j) { v[j] = v[j] - mean; q += (v[j][0] * v[j][0] + v[j][1] * v[j][1]) + (v[j][2] * v[j][2] + v[j][3] * v[j][3]); }
            const float rstd = 1.f / sqrtf(wave_sum(q) * (1.f / D_) + LN_EPS);
#pragma unroll
            for (int j = 0; j < 8; ++j) { const f32x4 gv = ((const f32x4*)g)[lane + 64 * j], bv = ((const f32x4*)b)[lane + 64 * j]; const f32x4 y = v[j] * rstd * gv + bv;
                ((f32x4*)(x1f + row * D_))[lane + 64 * j] = y; u32x2 pk = {cvtpk(y[0], y[1]), cvtpk(y[2], y[3])}; ((u32x2*)(x1b + row * D_))[lane + 64 * j] = pk; }
        }
        VM_WAIT(); __syncthreads();
        {
            f32x16 acc0 = {}, acc1 = {};
            const float* xr = x1f + ((size_t)rg * 32 + r32) * D_ + 256 * w + 4 * hi;
            const float* wr = Wr + (size_t)(256 * w + 4 * hi) * NE + r32;
#pragma unroll 4
            for (int q = 0; q < 32; ++q) { const f32x4 a4 = *(const f32x4*)(xr + 8 * q);
#pragma unroll
                for (int j = 0; j < 4; ++j) { const float b0 = wr[(8 * q + j) * NE], b1 = wr[(8 * q + j) * NE + 32];
                    acc0 = __builtin_amdgcn_mfma_f32_32x32x2f32(a4[j], b0, acc0, 0, 0, 0); acc1 = __builtin_amdgcn_mfma_f32_32x32x2f32(a4[j], b1, acc1, 0, 0, 0); } }
            LAS float* pw = part + w * 2048;
#pragma unroll
            for (int r = 0; r < 16; ++r) { pw[crow(r, hi) * 64 + r32] = acc0[r]; pw[crow(r, hi) * 64 + 32 + r32] = acc1[r]; }
        }
        __syncthreads();
        { const int tok = tid >> 4, e4 = (tid & 15) * 4; f32x4 s = {0.f, 0.f, 0.f, 0.f};
#pragma unroll
          for (int ww = 0; ww < 8; ++ww) s += *(const LAS f32x4*)(part + ww * 2048 + tok * 64 + e4);
          *(LAS f32x4*)(logits + tok * 64 + e4) = s; }
        __syncthreads();
        const float rb = rbias[lane];
#pragma unroll 1
        for (int i = 0; i < 4; ++i) {
            const int tok = w * 4 + i; const float x = logits[tok * 64 + lane];
            const float score = 1.f / (1.f + expf(-x)), sel = score + rb; const float NEG = -__builtin_inff();
            float m1 = sel; m1 = fmaxf(m1, __shfl_xor(m1, 1)); m1 = fmaxf(m1, __shfl_xor(m1, 2)); m1 = fmaxf(m1, __shfl_xor(m1, 4));
            const unsigned long long mk = __ballot(sel == m1); const unsigned grp = (unsigned)(mk >> (8 * (lane >> 3))) & 0xffu; const int first = __ffs((int)grp) - 1;
            float m2 = ((lane & 7) == first) ? NEG : sel; m2 = fmaxf(m2, __shfl_xor(m2, 1)); m2 = fmaxf(m2, __shfl_xor(m2, 2)); m2 = fmaxf(m2, __shfl_xor(m2, 4));
            const float gs = m1 + m2; int rank = 0;
#pragma unroll
            for (int g2 = 0; g2 < 8; ++g2) { const float og = __shfl(gs, g2 * 8); rank += (og > gs || (og == gs && g2 < (lane >> 3))) ? 1 : 0; }
            float mv = (rank < 4) ? sel : NEG; bool chosen = false;
#pragma unroll 1
            for (int it = 0; it < TOPK; ++it) { const float m = wave_max(mv); const unsigned long long cm = __ballot(mv == m); const int es = __ffsll((long long)cm) - 1; if (lane == es) { chosen = true; mv = NEG; } }
            const float wsum = wave_sum(chosen ? score : 0.f); const float wgt = score / wsum * 2.5f;
            const unsigned long long cmask = __ballot(chosen); const int kpos = __popcll(cmask & ((1ull << lane) - 1ull));
            if (chosen && kpos < TOPK) { const int lr = __hip_atomic_fetch_add((int*)(lcnt + lane), 1, __ATOMIC_RELAXED, __HIP_MEMORY_SCOPE_WORKGROUP);
                ent_e[tok * 8 + kpos] = lane; ent_w[tok * 8 + kpos] = wgt; ent_r[tok * 8 + kpos] = lr; }
        }
        __syncthreads();
        if (tid < 64) gbase[tid] = (int)__hip_atomic_fetch_add(gcnt + tid, (unsigned)lcnt[tid], RLX_AGENT);
        __syncthreads();
        if (tid < 256) { const int tok = tid >> 3, k = tid & 7, e = ent_e[tid], pos = gbase[e] + ent_r[tid]; const int t = rg * 32 + tok;
            tke[t * 8 + k] = e; tkp[t * 8 + k] = pos; roww[(size_t)e * S_ + pos] = ent_w[tid]; list[(size_t)e * S_ + pos] = t; }
        __syncthreads();
    }
}

__device__ __forceinline__ void phase_combine(LAS unsigned char* lds, unsigned char* ws, const float* g, const float* b, float* xo, bf16_t* xob, int L) {
    const int tid = opaque_tid(), lane = tid & 63, w = __builtin_amdgcn_readfirstlane(tid >> 6);
    build_prefix(lds, (const unsigned*)(ws + WS_CTL) + CW_CNT + 64 * L);
    const LAS int* tp = (const LAS int*)(lds + LDSCTL_OFF + 512);
    const float* x1f = (const float*)(ws + WS_X1F); const bf16_t* y = (const bf16_t*)(ws + WS_Y);
    const int* tke = (const int*)(ws + WS_TKE); const int* tkp = (const int*)(ws + WS_TKP);
    const int ysh = tp[64] * 256;
    for (int t = blockIdx.x * NWAVES + w; t < S_; t += gridDim.x * NWAVES) {
        int me = 0, mp = 0; if (lane < TOPK) { me = tke[t * 8 + lane]; mp = tkp[t * 8 + lane]; }
        const int myrow = (lane < TOPK) ? tp[me] * 256 + mp : ysh + t;
        f32x4 v[4][2];
#pragma unroll
        for (int j = 0; j < 4; ++j) { const float* xr = x1f + (size_t)t * D_ + 8 * lane + 512 * j; v[j][0] = *(const f32x4*)xr * ALPHA; v[j][1] = *(const f32x4*)(xr + 4) * ALPHA; }
#pragma unroll 1
        for (int k = 0; k < TOPK + 1; ++k) {
            const int yr = __shfl(myrow, k); const bf16_t* yp = y + (size_t)yr * D_ + 8 * lane;
#pragma unroll
            for (int j = 0; j < 4; ++j) { const u32x4 q = *(const u32x4*)(yp + 512 * j);
                v[j][0][0] += __uint_as_float(q[0] << 16); v[j][0][1] += __uint_as_float(q[0] & 0xffff0000u); v[j][0][2] += __uint_as_float(q[1] << 16); v[j][0][3] += __uint_as_float(q[1] & 0xffff0000u);
                v[j][1][0] += __uint_as_float(q[2] << 16); v[j][1][1] += __uint_as_float(q[2] & 0xffff0000u); v[j][1][2] += __uint_as_float(q[3] << 16); v[j][1][3] += __uint_as_float(q[3] & 0xffff0000u); }
        }
        float s = 0.f;
#pragma unroll
        for (int j = 0; j < 4; ++j) s += ((v[j][0][0] + v[j][0][1]) + (v[j][0][2] + v[j][0][3])) + ((v[j][1][0] + v[j][1][1]) + (v[j][1][2] + v[j][1][3]));
        const float mean = wave_sum(s) * (1.f / D_); float q2 = 0.f;
#pragma unroll
        for (int j = 0; j < 4; ++j) { v[j][0] = v[j][0] - mean; v[j][1] = v[j][1] - mean;
            q2 += ((v[j][0][0] * v[j][0][0] + v[j][0][1] * v[j][0][1]) + (v[j][0][2] * v[j][0][2] + v[j][0][3] * v[j][0][3])) + ((v[j][1][0] * v[j][1][0] + v[j][1][1] * v[j][1][1]) + (v[j][1][2] * v[j][1][2] + v[j][1][3] * v[j][1][3])); }
        const float rstd = 1.f / sqrtf(wave_sum(q2) * (1.f / D_) + LN_EPS);
#pragma unroll
        for (int j = 0; j < 4; ++j) { const int c = 8 * lane + 512 * j;
            const f32x4 y0 = v[j][0] * rstd * *(const f32x4*)(g + c) + *(const f32x4*)(b + c), y1 = v[j][1] * rstd * *(const f32x4*)(g + c + 4) + *(const f32x4*)(b + c + 4);
            *(f32x4*)(xo + (size_t)t * D_ + c) = y0; *(f32x4*)(xo + (size_t)t * D_ + c + 4) = y1;
            if (xob) { u32x4 pk = {cvtpk(y0[0], y0[1]), cvtpk(y0[2], y0[3]), cvtpk(y1[0], y1[1]), cvtpk(y1[2], y1[3])}; *(u32x4*)(xob + (size_t)t * D_ + c) = pk; } }
    }
}


struct ConvTile { const float* s0; bf16_t* d0; int ldN, ldK, nvalid; };
__device__ __forceinline__ void conv_load(const ConvTile& c, f32x4 (&v)[16], int lane) {
    const int q = lane >> 4, p = lane & 15; const bool ok = 4 * p + 3 < c.nvalid;
    const float* s = c.s0 + (size_t)(16 * q) * c.ldN + 4 * p;
#pragma unroll
    for (int i = 0; i < 16; ++i) v[i] = ok ? *(const f32x4*)(s + (size_t)i * c.ldN) : (f32x4){0.f, 0.f, 0.f, 0.f};
}
__device__ __forceinline__ void conv_store(const ConvTile& c, const f32x4 (&v)[16], LAS unsigned char* scr, int lane) {
    const int q = lane >> 4, p = lane & 15;
#pragma unroll
    for (int cc = 0; cc < 2; ++cc)
#pragma unroll
        for (int j = 0; j < 4; ++j) { u32x4 w = {cvtpk(v[8 * cc + 0][j], v[8 * cc + 1][j]), cvtpk(v[8 * cc + 2][j], v[8 * cc + 3][j]), cvtpk(v[8 * cc + 4][j], v[8 * cc + 5][j]), cvtpk(v[8 * cc + 6][j], v[8 * cc + 7][j])};
            *(LAS u32x4*)(scr + (4 * p + j) * 144 + (16 * q + 8 * cc) * 2) = w; }
    LDS_WAIT(); asm volatile("" ::: "memory");
#pragma unroll
    for (int i = 0; i < 8; ++i) { const int n = (lane >> 3) + 8 * i; const u32x4 w = *(const LAS u32x4*)(scr + n * 144 + (lane & 7) * 16);
        if (n < c.nvalid) *(u32x4*)(c.d0 + (size_t)n * c.ldK + 8 * (lane & 7)) = w; }
    LDS_WAIT(); asm volatile("" ::: "memory");
}
struct LayerPW { const float *wgu, *sgu, *wd, *sd; };
struct ConvJob { const float* src; bf16_t* dst; int K, N, nb, gu; size_t dstride; };
__device__ __forceinline__ int conv_tiles(const ConvJob& j) { return j.nb * (j.K / 64) * ((j.N + 63) / 64); }
__device__ __forceinline__ ConvTile conv_ref(const ConvJob& j, int t) {
    const int ntn = (j.N + 63) / 64, ntk = j.K / 64, per = ntk * ntn;
    const int bi = t / per, r = t - bi * per, kt = r / ntn, nt = r - kt * ntn;
    const int n0 = nt * 64; int nvalid = j.N - n0; if (nvalid > 64) nvalid = 64;
    int drow0 = n0; if (j.gu) drow0 = 256 * ((n0 & 511) >> 7) + 128 * (n0 >> 9) + (n0 & 127);
    ConvTile c; c.s0 = j.src + (size_t)bi * j.K * j.N + (size_t)(kt * 64) * j.N + n0; c.d0 = j.dst + (size_t)bi * j.dstride + (size_t)drow0 * j.K + kt * 64; c.ldN = j.N; c.ldK = j.K; c.nvalid = nvalid; return c;
}
__device__ __forceinline__ void conv_run(const ConvJob& j, int t, LAS unsigned char* scr, int lane) { f32x4 v[16]; const ConvTile c = conv_ref(j, t); conv_load(c, v, lane); conv_store(c, v, scr, lane); }
__device__ __forceinline__ void conv_chunk8(const ConvJob& j, int t0, LAS unsigned char* scr, int lane) {
    f32x4 va[16], vb[16];
    ConvTile ca = conv_ref(j, t0), cb; conv_load(ca, va, lane);
#pragma unroll 1
    for (int i = 0; i < 8; i += 2) {
        cb = conv_ref(j, t0 + i + 1); conv_load(cb, vb, lane);
        conv_store(ca, va, scr, lane);
        if (i + 2 < 8) { ca = conv_ref(j, t0 + i + 2); conv_load(ca, va, lane); }
        conv_store(cb, vb, scr, lane);
    }
}
__device__ __forceinline__ void phase_prologue(LAS unsigned char* lds, const Args& a) {
    const int tid = opaque_tid(), lane = tid & 63, w = __builtin_amdgcn_readfirstlane(tid >> 6);
    unsigned char* ws = a.ws;
    const int gw = blockIdx.x * NWAVES + w, NGW = gridDim.x * NWAVES;
    LAS unsigned char* scr = lds + w * 9216;
    { const f32x4* x4 = (const f32x4*)a.in[0]; u32x2* o = (u32x2*)(ws + WS_XB); const size_t n4 = (size_t)S_ * D_ / 4;
      for (size_t i = (size_t)blockIdx.x * 512 + tid; i < n4; i += (size_t)gridDim.x * 512) { const f32x4 v = x4[i]; u32x2 pk = {cvtpk(v[0], v[1]), cvtpk(v[2], v[3])}; o[i] = pk; } }
    for (int m = gw; m < NMEM; m += NGW) { const f32x4* tr = (const f32x4*)(a.in[1] + (size_t)m * D_) + lane; f32x4 v[8]; float s = 0.f;
#pragma unroll
        for (int j = 0; j < 8; ++j) { v[j] = tr[64 * j]; s += (v[j][0] + v[j][1]) + (v[j][2] + v[j][3]); }
        const float mean = wave_sum(s) * (1.f / D_); float q = 0.f;
#pragma unroll
        for (int j = 0; j < 8; ++j) { v[j] = v[j] - mean; q += (v[j][0] * v[j][0] + v[j][1] * v[j][1]) + (v[j][2] * v[j][2] + v[j][3] * v[j][3]); }
        const float rstd = 1.f / sqrtf(wave_sum(q) * (1.f / D_) + LN_EPS);
#pragma unroll
        for (int j = 0; j < 8; ++j) { const f32x4 y = v[j] * rstd * ((const f32x4*)a.in[2])[lane + 64 * j] + ((const f32x4*)a.in[3])[lane + 64 * j];
            u32x2 pk = {cvtpk(y[0], y[1]), cvtpk(y[2], y[3])}; ((u32x2*)(ws + WS_MEMN + (size_t)m * D_ * 2))[lane + 64 * j] = pk; } }
    { u32x4* z = (u32x4*)(ws + WS_WIN1 + (size_t)NQKV1 * D_ * 2); const size_t n = (size_t)(NQKV1P - NQKV1) * D_ * 2 / 16;
      for (size_t i = (size_t)blockIdx.x * 512 + tid; i < n; i += (size_t)gridDim.x * 512) z[i] = (u32x4){0u, 0u, 0u, 0u}; }
    ConvJob jobs[5];
    jobs[0] = ConvJob{a.in[5], (bf16_t*)(ws + WS_WIN0), D_, NQKV0, 1, 0, 0};
    jobs[1] = ConvJob{a.in[4], (bf16_t*)(ws + WS_WMEM), D_, 1024, 1, 0, 0};
    jobs[2] = ConvJob{a.in[6], (bf16_t*)(ws + WS_WO0), D_, D_, 1, 0, 0};
    jobs[3] = ConvJob{a.in[17], (bf16_t*)(ws + WS_WIN1), D_, NQKV1, 1, 0, 0};
    jobs[4] = ConvJob{a.in[19], (bf16_t*)(ws + WS_WO1), D_, D_, 1, 0, 0};
#pragma unroll
    for (int ji = 0; ji < 5; ++ji) { const int nt = conv_tiles(jobs[ji]);
        for (int t = gw; t < nt; t += NGW) conv_run(jobs[ji], t, scr, lane); }
}
constexpr int CW_QUEUE = 20480;
__device__ __forceinline__ void conv_moe(LAS unsigned char* lds, unsigned char* ws, const LayerPW& P, int L) {
    const int tid = opaque_tid(), lane = tid & 63, w = __builtin_amdgcn_readfirstlane(tid >> 6);
    LAS unsigned char* scr = lds + w * 9216;
    bf16_t* gu = (bf16_t*)(ws + (L == 0 ? WS_WGU0 : WS_WGU1)); bf16_t* dn = (bf16_t*)(ws + (L == 0 ? WS_WD0 : WS_WD1));
    const ConvJob j0{P.wgu, gu, D_, 1024, 64, 1, (size_t)1024 * D_}, j1{P.sgu, gu + (size_t)64 * 1024 * D_, D_, 1024, 1, 1, 0},
                  j2{P.wd, dn, EFF, D_, 64, 0, (size_t)D_ * EFF}, j3{P.sd, dn + (size_t)64 * D_ * EFF, EFF, D_, 1, 0, 0};
    constexpr int C0 = 64 * 32 * 16 / 8, C1 = C0 + 32 * 16 / 8, C2 = C1 + 64 * 8 * 32 / 8, C3 = C2 + 8 * 32 / 8;
    unsigned* qw = (unsigned*)(ws + WS_CTL) + CW_QUEUE + 64 * L;
    for (;;) {
        unsigned c = 0; if (lane == 0) c = __hip_atomic_fetch_add(qw, 1u, RLX_AGENT);
        const int ch = __builtin_amdgcn_readfirstlane((int)c);
        if (ch >= C3) break;
        if (ch < C0) conv_chunk8(j0, ch * 8, scr, lane); else if (ch < C1) conv_chunk8(j1, (ch - C0) * 8, scr, lane);
        else if (ch < C2) conv_chunk8(j2, (ch - C1) * 8, scr, lane); else conv_chunk8(j3, (ch - C2) * 8, scr, lane);
    }
}

namespace pg8 {
constexpr int BM = 256, BK = 64, HALF = 128, HTB = HALF * BK * 2, STAGE_BYTES = 8 * HTB, NXCD = 8, WGM = 8;
__host__ __device__ __forceinline__ int lds_byte(int r, int c) { const int st = (r >> 4) * 2 + (c >> 5), rr = r & 15, cc = c & 31, ob = rr * 64 + cc * 2; return st * 1024 + (ob ^ (((ob >> 9) & 1) << 5)); }
__host__ __device__ __forceinline__ void stage_rc(int b, int& R, int& C) { const int st = b / 1024, sb = b % 1024, swz = sb ^ (((sb >> 9) & 1) << 5); R = (st >> 1) * 16 + swz / 64; C = (st & 1) * 32 + (swz % 64) / 2; }
__host__ __device__ __forceinline__ int perm32(int rho) { const int n = rho >> 4, i = rho & 15; return 8 * (i >> 2) + 4 * n + (i & 3); }
struct Unit { int pm, pn, e, cnt, orow; };
struct PlainOrder {
    static constexpr bool GATHER = false;
    const bf16_t* A; const bf16_t* Bt; int K; int nM, nN, nwg, G, c;
    __device__ void init(const bf16_t* A_, const bf16_t* Bt_, int M, int N, int K_, int G_, int c_) { A = A_; Bt = Bt_; K = K_; nM = M / BM; nN = N / BM; nwg = nM * nN; G = G_; c = c_; }
    __device__ bool next(int i, Unit& u) const {
        const long L = (long)i * G + c; if (c < 0 || L >= nwg) return false;
        int wgid = (int)L; { const int q = nwg / NXCD, r = nwg % NXCD, xcd = wgid % NXCD, off = wgid / NXCD; wgid = (xcd < r ? xcd * (q + 1) : r * (q + 1) + (xcd - r) * q) + off; }
        const int nig = WGM * nN, gid = wgid / nig, fm = gid * WGM, gsz = (nM - fm) < WGM ? (nM - fm) : WGM;
        u.pm = fm + ((wgid % nig) % gsz); u.pn = (wgid % nig) / gsz; u.e = 0; u.cnt = 0; u.orow = u.pm * BM; return true;
    }
    __device__ __forceinline__ const char* a_base(const Unit& u) const { return (const char*)A + (size_t)u.pm * BM * K * 2; }
    __device__ __forceinline__ const char* b_base(const Unit& u) const { return (const char*)Bt + (size_t)u.pn * BM * K * 2; }
    __device__ __forceinline__ void gather_offs(const Unit&, int, int, int, int, unsigned (&)[4]) const {}
};
template <bool GATHER_> struct GroupedOrder {
    static constexpr bool GATHER = GATHER_;
    const bf16_t* A; const bf16_t* Bt; int K, Nexp  , npn, G, c; const LAS int* tp; const LAS int* cntl; const int* list; const LAS unsigned char* texp;
    __device__ bool next(int i, Unit& u) const {
        const int L = i * G + c, total = tp[65] * npn; if (L >= total) return false;
        const int tile = L / npn; u.pn = L - tile * npn; const int e = (int)texp[tile];
        u.e = e; u.pm = tile - tp[e]; u.cnt = cntl[e]; u.orow = tile * BM; return true;
    }
    __device__ __forceinline__ const char* a_base(const Unit& u) const { return GATHER ? (const char*)A : (const char*)A + (size_t)u.orow * K * 2; }
    __device__ __forceinline__ const char* b_base(const Unit& u) const { return (const char*)Bt + ((size_t)u.e * Nexp + (size_t)u.pn * BM) * K * 2; }
    __device__ __forceinline__ void gather_offs(const Unit& u, int R0, int C0, int R1, int C1, unsigned (&vo)[4]) const {
#pragma unroll
        for (int h = 0; h < 2; ++h) { const int l0 = u.pm * BM + h * HALF + R0, l1 = u.pm * BM + h * HALF + R1; int t0 = 0, t1 = 0;
            if (u.e < 64) { if (l0 < u.cnt) t0 = list[(size_t)u.e * S_ + l0]; if (l1 < u.cnt) t1 = list[(size_t)u.e * S_ + l1]; } else { t0 = l0; t1 = l1; }
            vo[2 * h] = (unsigned)(t0 * K + C0) * 2u; vo[2 * h + 1] = (unsigned)(t1 * K + C1) * 2u; }
    }
};

template <class Epi, class Sched>
__device__ __forceinline__ void gemm_phase(LAS unsigned char* lds, const Sched& S, const Epi& E) {
    constexpr bool GA = Sched::GATHER;
    const int tid = opaque_tid(), wid = __builtin_amdgcn_readfirstlane(tid >> 6), lane = tid & 63, wr = wid >> 2, wc = wid & 3, fr = lane & 15, fq = lane >> 4;
    const int K = S.K, nt = K / BK;
    unsigned voffA[2], voffB[2]; int Rs[2], Cs[2];
#pragma unroll
    for (int i = 0; i < 2; ++i) { int R, C; stage_rc(tid * 16 + i * 8192, R, C); Rs[i] = R; Cs[i] = C; const int Rb = Epi::PERM ? ((R & ~31) + perm32(R & 31)) : R;
        voffA[i] = (unsigned)(R * K + C) * 2u; voffB[i] = (unsigned)(Rb * K + C) * 2u; }
    const size_t kstep = (size_t)(BK * 2);
    const size_t hstep = (size_t)HALF * K * 2;
    const unsigned ldsw = (unsigned)wid * 1024u;
    const int aoff = lds_byte(wr * 64 + fr, fq * 8), boff = lds_byte(wc * 32 + fr, fq * 8);
#define PG8_SA(b, h) (((b) * 2 + (h)) * HTB)
#define PG8_SB(b, h) ((4 + (b) * 2 + (h)) * HTB)
#define PG8_GLDS(bufoff, gptr, off, i_) __builtin_amdgcn_global_load_lds((const unsigned*)((const char*)(gptr) + (off)), (LAS unsigned*)(lds + (bufoff) + ldsw + (i_) * 8192), 16, 0, 0)
#define PG8_STAGE_B(bufoff, gbase) do { PG8_GLDS(bufoff, gbase, voffB[0], 0); PG8_GLDS(bufoff, gbase, voffB[1], 1); } while (0)
#define PG8_STAGE_A(bufoff, kptr, h, nx) do { if constexpr (GA) { PG8_GLDS(bufoff, kptr, (nx) ? vgn[2 * (h)] : vgc[2 * (h)], 0); PG8_GLDS(bufoff, kptr, (nx) ? vgn[2 * (h) + 1] : vgc[2 * (h) + 1], 1); } \
        else { PG8_GLDS(bufoff, (kptr) + (h) * hstep, voffA[0], 0); PG8_GLDS(bufoff, (kptr) + (h) * hstep, voffA[1], 1); } } while (0)
#define PG8_LDA(dst, b, h) do { _Pragma("unroll") for (int m = 0; m < 4; ++m) _Pragma("unroll") for (int k = 0; k < 2; ++k) dst[m][k] = *(const LAS bf16x8*)(lds + PG8_SA(b, h) + aoff + m * 2048 + k * 1024); } while (0)
#define PG8_LDB(dst, b, h) do { _Pragma("unroll") for (int n = 0; n < 2; ++n) _Pragma("unroll") for (int k = 0; k < 2; ++k) dst[n][k] = *(const LAS bf16x8*)(lds + PG8_SB(b, h) + boff + n * 2048 + k * 1024); } while (0)
#define PG8_MMA(ai, bj, At, Bt) do { __builtin_amdgcn_s_setprio(1); _Pragma("unroll") for (int m = 0; m < 4; ++m) _Pragma("unroll") for (int n = 0; n < 2; ++n) _Pragma("unroll") for (int k = 0; k < 2; ++k) \
        acc[ai][bj][m][n] = __builtin_amdgcn_mfma_f32_16x16x32_bf16(Bt[n][k], At[m][k], acc[ai][bj][m][n], 0, 0, 0); __builtin_amdgcn_s_setprio(0); } while (0)
#define PG8_WAIT_V(n) asm volatile("s_waitcnt vmcnt(" #n ")" ::: "memory")
#define PG8_WAIT_L(n) asm volatile("s_waitcnt lgkmcnt(" #n ")" ::: "memory")
#define PG8_BAR __builtin_amdgcn_s_barrier()
#define PG8_SCHED __builtin_amdgcn_sched_barrier(0)
    Unit cur, nxt; int ui = 0;
    if (!S.next(0, cur)) return;
    f32x4 acc[2][2][4][2];
#pragma unroll
    for (int a = 0; a < 2; ++a)
#pragma unroll
        for (int b = 0; b < 2; ++b)
#pragma unroll
            for (int m = 0; m < 4; ++m)
#pragma unroll
                for (int n = 0; n < 2; ++n) acc[a][b][m][n] = (f32x4){0.f, 0.f, 0.f, 0.f};
    bf16x8 At[4][2], B0[2][2], B1[2][2];
    unsigned vgc[4] = {0u, 0u, 0u, 0u}, vgn[4] = {0u, 0u, 0u, 0u};
    if constexpr (GA) S.gather_offs(cur, Rs[0], Cs[0], Rs[1], Cs[1], vgc);
    const char* cA = S.a_base(cur); const char* cB = S.b_base(cur);
    PG8_STAGE_B(PG8_SB(0, 0), cB); PG8_STAGE_B(PG8_SB(0, 1), cB + hstep); PG8_STAGE_A(PG8_SA(0, 0), cA, 0, false); PG8_STAGE_A(PG8_SA(0, 1), cA, 1, false);
    if (wr == 1) PG8_BAR;
    PG8_WAIT_V(2); PG8_BAR;
    PG8_STAGE_B(PG8_SB(1, 0), cB + kstep); PG8_STAGE_A(PG8_SA(1, 0), cA + kstep, 0, false); PG8_STAGE_B(PG8_SB(1, 1), cB + hstep + kstep);
    PG8_WAIT_V(6); PG8_BAR;
    for (;;) {
        const bool has_next = S.next(ui + 1, nxt);
        if constexpr (GA) { if (has_next) S.gather_offs(nxt, Rs[0], Cs[0], Rs[1], Cs[1], vgn); }
        const char* nA = has_next ? S.a_base(nxt) : cA; const char* nB = has_next ? S.b_base(nxt) : cB;
        for (int t = 0; t < nt; t += 2) {
            const bool last = (t == nt - 2);
            const bool nx = last && has_next;
            const char* a1 = cA + (size_t)(t + 1) * kstep;
            const char* a2 = last ? nA : cA + (size_t)(t + 2) * kstep; const char* b2 = last ? nB : cB + (size_t)(t + 2) * kstep;
            const char* a3 = a2 + kstep; const char* b3 = b2 + kstep;
            PG8_LDB(B0, 0, 0); PG8_LDB(B1, 0, 1); PG8_SCHED; PG8_LDA(At, 0, 0); PG8_STAGE_A(PG8_SA(1, 1), a1, 1, false);
            PG8_WAIT_V(8); PG8_WAIT_L(0); PG8_BAR; PG8_MMA(0, 0, At, B0); PG8_MMA(0, 1, At, B1); PG8_BAR; PG8_SCHED;
            PG8_LDA(At, 0, 1); PG8_STAGE_B(PG8_SB(0, 0), b2); PG8_STAGE_B(PG8_SB(0, 1), b2 + hstep); PG8_STAGE_A(PG8_SA(0, 0), a2, 0, nx);
            PG8_WAIT_V(8); PG8_WAIT_L(0); PG8_BAR; PG8_MMA(1, 0, At, B0); PG8_MMA(1, 1, At, B1); PG8_BAR; PG8_SCHED;
            PG8_LDB(B0, 1, 0); PG8_LDB(B1, 1, 1); PG8_SCHED; PG8_LDA(At, 1, 0); PG8_STAGE_A(PG8_SA(0, 1), a2, 1, nx);
            PG8_WAIT_V(8); PG8_WAIT_L(0); PG8_BAR; PG8_MMA(0, 0, At, B0); PG8_MMA(0, 1, At, B1); PG8_BAR; PG8_SCHED;
            PG8_LDA(At, 1, 1); PG8_STAGE_B(PG8_SB(1, 0), b3); PG8_STAGE_B(PG8_SB(1, 1), b3 + hstep); PG8_STAGE_A(PG8_SA(1, 0), a3, 0, nx);
            PG8_WAIT_V(8); PG8_WAIT_L(0); PG8_BAR; PG8_MMA(1, 0, At, B0); PG8_MMA(1, 1, At, B1); PG8_BAR; PG8_SCHED;
        }
        if (wr == 0) PG8_BAR;
        E(acc, cur, wr, wc, fr, fq);
        if (!has_next) break;
#pragma unroll
        for (int a = 0; a < 2; ++a)
#pragma unroll
            for (int b = 0; b < 2; ++b)
#pragma unroll
                for (int m = 0; m < 4; ++m)
#pragma unroll
                    for (int n = 0; n < 2; ++n) acc[a][b][m][n] = (f32x4){0.f, 0.f, 0.f, 0.f};
        cur = nxt; cA = nA; cB = nB; ++ui;
        if constexpr (GA) {
#pragma unroll
            for (int i = 0; i < 4; ++i) vgc[i] = vgn[i]; }
        if (wr == 1) PG8_BAR;
    }
    PG8_WAIT_V(0);
    PG8_BAR;
#undef PG8_SA
#undef PG8_SB
#undef PG8_GLDS
#undef PG8_STAGE_A
#undef PG8_STAGE_B
#undef PG8_LDA
#undef PG8_LDB
#undef PG8_MMA
#undef PG8_WAIT_V
#undef PG8_WAIT_L
#undef PG8_BAR
#undef PG8_SCHED
}

struct EpiHead {
    static constexpr bool PERM = true;
    bf16_t* dst; int rows; int nheads; int qscale; float* flog;
    __device__ __forceinline__ void operator()(const f32x4 (&acc)[2][2][4][2], const Unit& u, int wr, int wc, int fr, int fq) const {
#pragma unroll
        for (int bj = 0; bj < 2; ++bj) { const int head = 2 * u.pn + bj;
            if (head < nheads) { const float sc = (qscale && (head < 12 || head >= 36)) ? QSCALE : 1.f;
                bf16_t* base = dst + (size_t)head * rows * HD + wc * 32 + 8 * fq;
#pragma unroll
                for (int ai = 0; ai < 2; ++ai)
#pragma unroll
                    for (int m = 0; m < 4; ++m) { const int row = u.orow + ai * HALF + wr * 64 + m * 16 + fr; const f32x4 v0 = acc[ai][bj][m][0] * sc, v1 = acc[ai][bj][m][1] * sc;
                        u32x4 w = {cvtpk(v0[0], v0[1]), cvtpk(v0[2], v0[3]), cvtpk(v1[0], v1[1]), cvtpk(v1[2], v1[3])}; *(u32x4*)(base + (size_t)row * HD) = w; } }
            else if (flog && head == nheads && wc == 0 && fq < 2) {
#pragma unroll
                for (int ai = 0; ai < 2; ++ai)
#pragma unroll
                    for (int m = 0; m < 4; ++m) { const int row = u.orow + ai * HALF + wr * 64 + m * 16 + fr;
#pragma unroll
                        for (int n = 0; n < 2; ++n)
#pragma unroll
                            for (int j = 0; j < 4; ++j) { const int c = 8 * fq + 4 * n + j; if (c < NH) flog[(size_t)c * S_ + row] = acc[ai][bj][m][n][j]; } } }
        }
    }
};
struct EpiT1 {
    static constexpr bool PERM = false;
    const float* x; float* t1;
    __device__ __forceinline__ void operator()(const f32x4 (&acc)[2][2][4][2], const Unit& u, int wr, int wc, int fr, int fq) const {
        const int col0 = u.pn * BM + wc * 32 + 4 * fq;
#pragma unroll
        for (int ai = 0; ai < 2; ++ai)
#pragma unroll
            for (int m = 0; m < 4; ++m) { const size_t off = (size_t)(u.orow + ai * HALF + wr * 64 + m * 16 + fr) * D_ + col0;
#pragma unroll
                for (int bj = 0; bj < 2; ++bj)
#pragma unroll
                    for (int n = 0; n < 2; ++n) { const f32x4 xs = *(const f32x4*)(x + off + bj * HALF + n * 16); *(f32x4*)(t1 + off + bj * HALF + n * 16) = xs * ALPHA + acc[ai][bj][m][n]; }
                if (m & 1) asm volatile("" ::: "memory"); }
    }
};
struct EpiGU {
    static constexpr bool PERM = true;
    bf16_t* h;
    __device__ __forceinline__ void operator()(const f32x4 (&acc)[2][2][4][2], const Unit& u, int wr, int wc, int fr, int fq) const {
        bf16_t* base = h + u.pn * HALF + wc * 32 + 8 * fq;
#pragma unroll
        for (int ai = 0; ai < 2; ++ai)
#pragma unroll
            for (int m = 0; m < 4; ++m) { const int row = u.orow + ai * HALF + wr * 64 + m * 16 + fr; float o[8];
#pragma unroll
                for (int n = 0; n < 2; ++n)
#pragma unroll
                    for (int j = 0; j < 4; ++j) { const float g = acc[ai][0][m][n][j], up = acc[ai][1][m][n][j];
                        o[4 * n + j] = g * __builtin_amdgcn_rcpf(1.f + __builtin_amdgcn_exp2f(-g * LOG2E)) * up; }
                u32x4 w = {cvtpk(o[0], o[1]), cvtpk(o[2], o[3]), cvtpk(o[4], o[5]), cvtpk(o[6], o[7])}; *(u32x4*)(base + (size_t)row * EFF) = w; }
    }
};
struct EpiDown {
    static constexpr bool PERM = true;
    bf16_t* y; const float* roww;
    __device__ __forceinline__ void operator()(const f32x4 (&acc)[2][2][4][2], const Unit& u, int wr, int wc, int fr, int fq) const {
        bf16_t* base = y + u.pn * BM + wc * 32 + 8 * fq;
#pragma unroll
        for (int ai = 0; ai < 2; ++ai)
#pragma unroll
            for (int m = 0; m < 4; ++m) { const int lr = u.pm * BM + ai * HALF + wr * 64 + m * 16 + fr; const int row = u.orow + ai * HALF + wr * 64 + m * 16 + fr;
                float gt = 0.f; if (lr < u.cnt) gt = (u.e < 64) ? roww[(size_t)u.e * S_ + lr] : 1.f;
#pragma unroll
                for (int bj = 0; bj < 2; ++bj) { const f32x4 v0 = acc[ai][bj][m][0] * gt, v1 = acc[ai][bj][m][1] * gt;
                    u32x4 w = {cvtpk(v0[0], v0[1]), cvtpk(v0[2], v0[3]), cvtpk(v1[0], v1[1]), cvtpk(v1[2], v1[3])}; *(u32x4*)(base + (size_t)row * D_ + bj * HALF) = w; } }
    }
};
}


namespace at {
constexpr int NW = 8, QBLK = 32, KVBLK = 64, QB = NW * QBLK, SHM_V = KVBLK * HD * 2, SHM_K = KVBLK * HD * 2;
constexpr int WS_OFF = 2 * SHM_V + 2 * SHM_K, TAB_OFF = WS_OFF + NW * 64 * 4, ZERO_OFF = TAB_OFF + S_ * 4, ATT_END = ZERO_OFF + 1024;
constexpr float THR = 8.f;
static_assert(ATT_END <= RING_BYTES, "attention LDS");
#define KSWZ(row, colB) ((row) * 256 + ((colB) ^ (((row) & 7) << 4)))
#define SBAR() __builtin_amdgcn_sched_barrier(0)
__device__ __forceinline__ int v_st(int k, int c) { const int kk = (k & ~0xC) | ((k & 4) << 1) | ((k & 8) >> 1); return ((kk >> 3) * 4 + (c >> 5)) * 512 + ((kk & 7) * 32 + (c & 31)) * 2; }
__device__ __forceinline__ int v_rd_base(int lane) { return ((lane & 3) << 3) | (((lane >> 2) & 3) << 6) | (((lane >> 4) & 1) << 5) | (((lane >> 5) & 1) << 8); }
constexpr int v_rd_off(int d0, int ks, int half) { return d0 * 512 + ks * 4096 + half * 2048; }
__device__ __forceinline__ bf16x8 load8(const bf16_t* p) { return *reinterpret_cast<const bf16x8*>(p); }
__device__ __forceinline__ void mask_tile(f32x16& p0, f32x16& p1, int dq, unsigned W) {
    const float NEG = -__builtin_inff();
#pragma unroll
    for (int r = 0; r < 16; ++r) { const int c = (r & 3) + 8 * (r >> 2);
        if ((unsigned)(dq - c) >= W) p0[r] = NEG;
        if ((unsigned)(dq - c - 32) >= W) p1[r] = NEG; }
}
#define PK4(P, B_, OUT) do { unsigned a0 = cvtpk(P[B_+0], P[B_+1]), a1 = cvtpk(P[B_+2], P[B_+3]);                          \
        unsigned b0 = cvtpk(P[B_+4], P[B_+5]), b1 = cvtpk(P[B_+6], P[B_+7]);                                             \
        auto r0 = __builtin_amdgcn_permlane32_swap(a0, b0, false, false); auto r1 = __builtin_amdgcn_permlane32_swap(a1, b1, false, false); \
        u32x4 w = {r0[0], r1[0], r0[1], r1[1]}; OUT = *reinterpret_cast<bf16x8*>(&w); } while (0)
__device__ __forceinline__ void partialSM(f32x16& p0, f32x16& p1, float& m_reg, float& mn, float& alpha) {
    float pmax = p0[0];
#pragma unroll
    for (int r = 1; r < 16; ++r) pmax = fmaxf(pmax, p0[r]);
#pragma unroll
    for (int r = 0; r < 16; ++r) pmax = fmaxf(pmax, p1[r]);
    { auto rr = __builtin_amdgcn_permlane32_swap(__float_as_uint(pmax), __float_as_uint(pmax), false, false);
      pmax = fmaxf(__uint_as_float(rr[0]), __uint_as_float(rr[1])); }
    if (__builtin_expect(__all((pmax - m_reg) <= THR), 1)) { mn = m_reg; alpha = 1.f; }
    else { mn = fmaxf(m_reg, pmax); alpha = __builtin_amdgcn_exp2f(m_reg - mn); m_reg = mn; }
#pragma unroll
    for (int r = 0; r < 16; ++r) p0[r] = p0[r] - mn;
#pragma unroll
    for (int r = 0; r < 16; ++r) p1[r] = p1[r] - mn;
#pragma unroll
    for (int r = 0; r < 16; ++r) p0[r] = __builtin_amdgcn_exp2f(p0[r]);
}
__device__ __forceinline__ void finishSM(f32x16& p0, f32x16& p1, float alpha, float& l_reg, bf16x8& pa0, bf16x8& pa1, bf16x8& pa2, bf16x8& pa3) {
#pragma unroll
    for (int r = 0; r < 16; ++r) p1[r] = __builtin_amdgcn_exp2f(p1[r]);
    float ps = 0;
#pragma unroll
    for (int r = 0; r < 16; ++r) ps += p0[r];
#pragma unroll
    for (int r = 0; r < 16; ++r) ps += p1[r];
    { auto rr = __builtin_amdgcn_permlane32_swap(__float_as_uint(ps), __float_as_uint(ps), false, false);
      ps = __uint_as_float(rr[0]) + __uint_as_float(rr[1]); }
    l_reg = l_reg * alpha + ps;
    PK4(p0, 0, pa0); PK4(p0, 8, pa1); PK4(p1, 0, pa2); PK4(p1, 8, pa3);
}
__device__ __forceinline__ void partialSB(f32x16& p0, f32x16& p1, float (&E)[8], float& tot, int hi) {
#pragma unroll
    for (int r = 0; r < 16; ++r) p0[r] = __builtin_amdgcn_rcpf(1.f + __builtin_amdgcn_exp2f(p0[r]));
#pragma unroll
    for (int r = 0; r < 16; ++r) p1[r] = __builtin_amdgcn_rcpf(1.f + __builtin_amdgcn_exp2f(p1[r]));
    float Glo[8], Ghi[8];
#pragma unroll
    for (int m = 0; m < 8; ++m) { const int b = 4 * (m & 3); const float G = (m < 4) ? (p0[b] * p0[b + 1]) * (p0[b + 2] * p0[b + 3]) : (p1[b] * p1[b + 1]) * (p1[b + 2] * p1[b + 3]);
        auto rr = __builtin_amdgcn_permlane32_swap(__float_as_uint(G), __float_as_uint(G), false, false); Glo[m] = __uint_as_float(rr[0]); Ghi[m] = __uint_as_float(rr[1]); }
    float st = 1.f;
#pragma unroll
    for (int m = 7; m >= 0; --m) { const float e1 = st * Ghi[m]; E[m] = hi ? st : e1; st = e1 * Glo[m]; }
    tot = st;
}
__device__ __forceinline__ void finishSB(f32x16& p0, f32x16& p1, const float (&E)[8], float tot, float& R, bf16x8& pa0, bf16x8& pa1, bf16x8& pa2, bf16x8& pa3) {
#pragma unroll
    for (int m = 0; m < 8; ++m) { const int b = 4 * (m & 3); float a = E[m] * R;
        if (m < 4) { const float w3 = fmaf(-a, p0[b + 3], a); a *= p0[b + 3]; const float w2 = fmaf(-a, p0[b + 2], a); a *= p0[b + 2]; const float w1 = fmaf(-a, p0[b + 1], a); a *= p0[b + 1]; const float w0 = fmaf(-a, p0[b], a);
            p0[b] = w0; p0[b + 1] = w1; p0[b + 2] = w2; p0[b + 3] = w3; }
        else { const float w3 = fmaf(-a, p1[b + 3], a); a *= p1[b + 3]; const float w2 = fmaf(-a, p1[b + 2], a); a *= p1[b + 2]; const float w1 = fmaf(-a, p1[b + 1], a); a *= p1[b + 1]; const float w0 = fmaf(-a, p1[b], a);
            p1[b] = w0; p1[b + 1] = w1; p1[b + 2] = w2; p1[b + 3] = w3; } }
    R *= tot;
    PK4(p0, 0, pa0); PK4(p0, 8, pa1); PK4(p1, 0, pa2); PK4(p1, 8, pa3);
}
#undef PK4
template <int KB, int MODE>
__device__ __forceinline__ void qkt(f32x16& p0, f32x16& p1, const char* K_lds, int r32, int hi, const bf16x8* qr, const float* tabk) {
    if (MODE == 1) {
#pragma unroll
        for (int m = 0; m < 4; ++m) { const f32x4 a = *(const f32x4*)(tabk + 8 * m), b = *(const f32x4*)(tabk + 32 + 8 * m);
#pragma unroll
            for (int j = 0; j < 4; ++j) { p0[4 * m + j] = a[j]; p1[4 * m + j] = b[j]; } }
    } else { p0 = f32x16{}; p1 = f32x16{}; }
    const char* kb[4];
#pragma unroll
    for (int dd = 0; dd < 4; ++dd) kb[dd] = K_lds + KB * SHM_K + KSWZ(r32, (dd * 16 + hi * 8) * 2);
#pragma unroll
    for (int d0 = 0; d0 < 8; ++d0) { const char* a = kb[d0 & 3] + (d0 >> 2) * 128;
        bf16x8 b0 = *reinterpret_cast<const bf16x8*>(a);
        bf16x8 b1 = *reinterpret_cast<const bf16x8*>(a + 32 * 256);
        p0 = __builtin_amdgcn_mfma_f32_32x32x16_bf16(b0, qr[d0], p0, 0, 0, 0);
        p1 = __builtin_amdgcn_mfma_f32_32x32x16_bf16(b1, qr[d0], p1, 0, 0, 0); }
}
template <int VB>
__device__ __forceinline__ void pv_tile(f32x16* o, int vb0, bf16x8 pa0, bf16x8 pa1, bf16x8 pa2, bf16x8 pa3) {
#define TRRD(dst, off) asm volatile("ds_read_b64_tr_b16 %0, %1 offset:%2" : "=&v"(dst) : "v"(vb0), "i"(off) : "memory")
#define PV_D0(d0) do { s16x4 l0, l1, l2, l3, h0, h1, h2, h3; constexpr int b_ = VB * SHM_V + v_rd_off(d0, 0, 0); \
        TRRD(l0, b_); TRRD(h0, b_ + 2048); TRRD(l1, b_ + 4096); TRRD(h1, b_ + 6144); TRRD(l2, b_ + 8192); TRRD(h2, b_ + 10240); TRRD(l3, b_ + 12288); TRRD(h3, b_ + 14336); \
        asm volatile("s_waitcnt lgkmcnt(0)" ::: "memory"); SBAR();   \
        o[d0] = __builtin_amdgcn_mfma_f32_32x32x16_bf16(pa0, (bf16x8){l0[0], l0[1], l0[2], l0[3], h0[0], h0[1], h0[2], h0[3]}, o[d0], 0, 0, 0);   \
        o[d0] = __builtin_amdgcn_mfma_f32_32x32x16_bf16(pa1, (bf16x8){l1[0], l1[1], l1[2], l1[3], h1[0], h1[1], h1[2], h1[3]}, o[d0], 0, 0, 0);   \
        o[d0] = __builtin_amdgcn_mfma_f32_32x32x16_bf16(pa2, (bf16x8){l2[0], l2[1], l2[2], l2[3], h2[0], h2[1], h2[2], h2[3]}, o[d0], 0, 0, 0);   \
        o[d0] = __builtin_amdgcn_mfma_f32_32x32x16_bf16(pa3, (bf16x8){l3[0], l3[1], l3[2], l3[3], h3[0], h3[1], h3[2], h3[3]}, o[d0], 0, 0, 0); } while (0)
    PV_D0(0); PV_D0(1); PV_D0(2); PV_D0(3);
#undef PV_D0
#undef TRRD
}
struct BlockRef { const bf16_t* Q; const bf16_t* K; const bf16_t* V; bf16_t* O; int P0, skv, tab; };
struct Seam { bf16x8 qr[8]; bf16x8 st_v0, st_v1, st_k0, st_k1; };
__device__ __forceinline__ int blk_jhi(const BlockRef& b) { int j = (b.P0 + QB - 1) / KVBLK + 1; const int mx = b.skv / KVBLK; return j > mx ? mx : j; }
template <int MODE> __device__ __forceinline__ int first_kb(const BlockRef& b) { return MODE == 0 ? (blk_jhi(b) - 1) * KVBLK : 0; }
#define ROW(p, k0, rr) ((p) + (size_t)((k0) + (rr)) * HD + sc)
#define VMW() asm volatile("s_waitcnt vmcnt(0)" ::: "memory")
#define VMWN(n) asm volatile("s_waitcnt vmcnt(%0)" :: "i"(n) : "memory")
#define SLOAD_H(Kp, Vp, k0) do { S.st_v0 = load8(ROW(Vp, k0, sr)); S.st_v1 = load8(ROW(Vp, k0, 32 + sr)); S.st_k0 = load8(ROW(Kp, k0, sr)); S.st_k1 = load8(ROW(Kp, k0, 32 + sr)); } while (0)
#define SWRITE_HK(bf) do { *(bf16x8*)(K_lds + (bf) * SHM_K + kws) = S.st_k0; *(bf16x8*)(K_lds + (bf) * SHM_K + kws + 32 * 256) = S.st_k1; } while (0)
#define SWRITE_HV(bf) do { *(bf16x8*)(V_lds + (bf) * SHM_V + vst0) = S.st_v0; *(bf16x8*)(V_lds + (bf) * SHM_V + vst1) = S.st_v1; } while (0)
#define SWRITE_H(bf) do { SWRITE_HV(bf); SWRITE_HK(bf); } while (0)
template <int MODE>
__device__ __forceinline__ void attn_prime(const BlockRef& cur, char* lds, Seam& S) {
    const int tid = opaque_tid(), wid = __builtin_amdgcn_readfirstlane(tid >> 6), lane = tid & 63, r32 = lane & 31, hi = lane >> 5;
    const int sr = tid >> 4, sc = (tid & 15) * 8, kws = KSWZ(sr, sc * 2); char* K_lds = lds + 2 * SHM_V;
    const int kb0 = first_kb<MODE>(cur);
#pragma unroll
    for (int d0 = 0; d0 < 8; ++d0) S.qr[d0] = load8(cur.Q + (size_t)(wid * QBLK + r32) * HD + d0 * 16 + hi * 8);
    SLOAD_H(cur.K, cur.V, kb0); VMW(); SWRITE_HK(0);
    __syncthreads();
}
template <int MODE>
__device__ __forceinline__ void attn_block(const BlockRef& cur, const BlockRef& nxt, char* lds, Seam& S) {
    const int tid = opaque_tid(), wid = __builtin_amdgcn_readfirstlane(tid >> 6), lane = tid & 63, r32 = lane & 31, hi = lane >> 5;
    const int j_hi = blk_jhi(cur), NT = j_hi;
    const int kbn = first_kb<MODE>(nxt);
    const int qlo = cur.P0 + wid * QBLK, qm = qlo + r32 - 4 * hi;
    char* V_lds = lds; char* K_lds = lds + 2 * SHM_V;
    float* wsf = (float*)(lds + WS_OFF) + wid * 64; float* li_l = wsf, * al_l = wsf + 32;
    const float* tabp = (const float*)(lds + cur.tab) + 4 * hi;
    float m_reg = -1e30f, l_reg = 0.f, Rrun = 1.f, tot = 1.f; float E[8]; f32x16 o[4] = {};
    const int sr = tid >> 4, sc = (tid & 15) * 8, vst0 = v_st(sr, sc), vst1 = v_st(32 + sr, sc), kws = KSWZ(sr, sc * 2);
    const int vb0 = (int)(uintptr_t)V_lds + v_rd_base(lane);
    const bf16_t* Kh = cur.K; const bf16_t* Vh = cur.V;
#define RESC(a) do { if (MODE == 1) { if (__any((a) < 1.f)) { if (hi == 0) al_l[r32] = (a); asm volatile("s_waitcnt lgkmcnt(0)" ::: "memory");              \
                     for (int d_ = 0; d_ < 4; ++d_) for (int r = 0; r < 16; ++r) o[d_][r] *= al_l[crow(r, hi)]; } } } while (0)
#define KBASE(t) ((MODE == 0 ? (j_hi - 1 - (t)) : (t)) * KVBLK)
#define MASKT(P0_, P1_, t) do { const int kb_ = KBASE(t); if (MODE == 0) { if (kb_ + KVBLK - 1 >= qlo) mask_tile(P0_, P1_, qm - kb_ - 1, 0x7fffffffu); } \
                                else { if (kb_ + KVBLK - 1 > qlo) mask_tile(P0_, P1_, qm - kb_, 0x7fffffffu); } } while (0)
#define PARTIAL(PX0, PX1, mnX, alX) do { if (MODE == 0) partialSB(PX0, PX1, E, tot, hi); else partialSM(PX0, PX1, m_reg, mnX, alX); } while (0)
#define FINISH(PY0, PY1, alY) do { if (MODE == 0) finishSB(PY0, PY1, E, tot, Rrun, pa0, pa1, pa2, pa3); else finishSM(PY0, PY1, alY, l_reg, pa0, pa1, pa2, pa3); } while (0)
    constexpr int NQL = 8;
#define SEAM_K0() do { VMWN(NQL); SWRITE_HK(0); SBAR(); } while (0)
    f32x16 pA0, pA1, pB0, pB1; float mnA = 0.f, mnB = 0.f, alA = 1.f, alB = 1.f; bf16x8 pa0, pa1, pa2, pa3;
    SWRITE_HV(0); SBAR();
    if (NT > 1) SLOAD_H(Kh, Vh, KBASE(1));
    SBAR(); qkt<0, MODE>(pA0, pA1, K_lds, r32, hi, S.qr, tabp + KBASE(0));
    MASKT(pA0, pA1, 0); PARTIAL(pA0, pA1, mnA, alA);
    if (NT > 1) { VMW(); SWRITE_H(1); }
    __syncthreads();
#define HALF_STEP(PX0, PX1, mnX, alX, PY0, PY1, alY, t, KB, VB, SB) do {                                                      \
        SBAR(); qkt<KB, MODE>(PX0, PX1, K_lds, r32, hi, S.qr, tabp + KBASE(t));                                              \
        FINISH(PY0, PY1, alY); SBAR();                                                                                        \
        if ((t) + 1 < NT) { SLOAD_H(Kh, Vh, KBASE((t) + 1)); SBAR(); }                                                        \
        pv_tile<VB>(o, vb0, pa0, pa1, pa2, pa3); MASKT(PX0, PX1, (t)); PARTIAL(PX0, PX1, mnX, alX);                           \
        __syncthreads();                                                                                                      \
        if ((t) + 1 < NT) { VMW(); SWRITE_H(SB); }                                                                            \
        RESC(alX); __syncthreads(); } while (0)
    for (int t = 1; t + 1 < NT; t += 2) {
        HALF_STEP(pB0, pB1, mnB, alB, pA0, pA1, alA, t, 1, 0, 0);
        HALF_STEP(pA0, pA1, mnA, alA, pB0, pB1, alB, t + 1, 0, 1, 1);
    }
    const bool even = (NT & 1) == 0;
    if (even) { SBAR(); qkt<1, MODE>(pB0, pB1, K_lds, r32, hi, S.qr, tabp + KBASE(NT - 1)); SBAR(); }
    SLOAD_H(nxt.K, nxt.V, kbn); SBAR();
#pragma unroll
    for (int d0 = 0; d0 < 8; ++d0) S.qr[d0] = load8(nxt.Q + (size_t)(wid * QBLK + r32) * HD + d0 * 16 + hi * 8);
    SBAR();
    FINISH(pA0, pA1, alA); SBAR();
    pv_tile<0>(o, vb0, pa0, pa1, pa2, pa3);
    if (even) { MASKT(pB0, pB1, NT - 1); PARTIAL(pB0, pB1, mnB, alB); __syncthreads(); RESC(alB);
        FINISH(pB0, pB1, alB); SBAR(); pv_tile<1>(o, vb0, pa0, pa1, pa2, pa3); }
    SBAR(); SEAM_K0();
    float rli[16];
    if (MODE == 1) { if (hi == 0) li_l[r32] = l_reg; asm volatile("s_waitcnt lgkmcnt(0)" ::: "memory");
#pragma unroll
        for (int r = 0; r < 16; ++r) rli[r] = __builtin_amdgcn_rcpf(li_l[crow(r, hi)]); }
    bf16_t* Ow = cur.O + (size_t)(wid * QBLK) * D_;
#pragma unroll
    for (int r = 0; r < 16; ++r) { const int orow = crow(r, hi);
#pragma unroll
        for (int d0 = 0; d0 < 4; ++d0) { const float v = (MODE == 1) ? o[d0][r] * rli[r] : o[d0][r];
            const float vn = __shfl_xor(v, 1);
            if ((r32 & 1) == 0) *(unsigned*)(Ow + (size_t)orow * D_ + d0 * 32 + r32) = cvtpk(v, vn); } }
    __syncthreads();
#undef RESC
#undef KBASE
#undef MASKT
#undef PARTIAL
#undef FINISH
#undef SEAM_K0
#undef HALF_STEP
}
#undef ROW
#undef VMW
#undef VMWN
#undef SLOAD_H
#undef SWRITE_HK
#undef SWRITE_HV
#undef SWRITE_H
__device__ __forceinline__ void fox_table(char* lds, const float* flogh, float bias) {
    const int tid = opaque_tid(), lane = tid & 63, wid = tid >> 6;
    float* tab = (float*)(lds + TAB_OFF); float* wt = (float*)(lds + WS_OFF);
    float p[16]; const f32x4* src = (const f32x4*)(flogh + 16 * tid);
#pragma unroll
    for (int i = 0; i < 4; ++i) { const f32x4 v = src[i];
#pragma unroll
        for (int j = 0; j < 4; ++j) p[4 * i + j] = softplusf(-(v[j] + bias)) * LOG2E; }
#pragma unroll
    for (int i = 1; i < 16; ++i) p[i] += p[i - 1];
    float inc = p[15];
#pragma unroll
    for (int off = 1; off < 64; off <<= 1) { const float v = __shfl_up(inc, off); if (lane >= off) inc += v; }
    if (lane == 63) wt[wid] = inc;
    __syncthreads();
    float base = inc - p[15];
    for (int w2 = 0; w2 < wid; ++w2) base += wt[w2];
#pragma unroll
    for (int i = 0; i < 16; ++i) tab[16 * tid + i] = base + p[i];
    __syncthreads();
}
}

__device__ __forceinline__ void phase_attention(unsigned char* shm, unsigned char* ws, int L, const float* fbias, const LayerPW& PW, bool do_conv) {
    char* lds = (char*)shm;
    const int tid0 = opaque_tid();
    { float* z = (float*)(lds + at::ZERO_OFF); if (tid0 < 256) z[tid0] = 0.f; }
    __syncthreads();
    const bf16_t* qkv = (const bf16_t*)(ws + WS_QKV); const bf16_t* kvm = (const bf16_t*)(ws + WS_KVMEM); bf16_t* ao = (bf16_t*)(ws + WS_AO);
    for (int v = blockIdx.x; v < 256; v += gridDim.x) {
        const bool mix = v < 192;
        const int head = mix ? (v >> 4) : ((v - 192) >> 4);
        const int q0 = mix ? (v & 15) : (((v - 192) * 2) & 31), q1 = mix ? 31 - q0 : q0 + 1;
        const bf16_t* Qh = qkv + (size_t)(mix ? head : 36 + head) * S_ * HD;
        const bf16_t* Kh = mix ? qkv + (size_t)(12 + head) * S_ * HD : kvm + (size_t)head * NMEM * HD;
        const bf16_t* Vh = mix ? qkv + (size_t)(24 + head) * S_ * HD : kvm + (size_t)(4 + head) * NMEM * HD;
        bf16_t* Oh = ao + (mix ? head : 12 + head) * HD;
        const int skv = mix ? S_ : NMEM, tab = mix ? at::TAB_OFF : at::ZERO_OFF;
#define MKREF(qb) at::BlockRef{Qh + (size_t)(qb) * 256 * HD, Kh, Vh, Oh + (size_t)(qb) * 256 * D_, mix ? (qb) * 256 : NMEM, skv, tab}
        at::Seam S;
        if (L == 0 && mix) {
            at::attn_prime<0>(MKREF(q0), lds, S);
#pragma unroll 1
            for (int i = 0; i < 2; ++i) at::attn_block<0>(MKREF(i ? q1 : q0), MKREF(q1), lds, S);
        } else {
            if (mix) at::fox_table(lds, (const float*)(ws + WS_FLOG) + (size_t)head * S_, fbias[head]);
            at::attn_prime<1>(MKREF(q0), lds, S);
#pragma unroll 1
            for (int i = 0; i < 2; ++i) at::attn_block<1>(MKREF(i ? q1 : q0), MKREF(q1), lds, S);
        }
#undef MKREF
    }
    if (do_conv) conv_moe((LAS unsigned char*)shm, ws, PW, L);
}

struct LayerP { const float *w_in, *fbias, *w_o, *g1, *b1, *router, *rbias, *wgu, *wd, *sgu, *sd, *g2, *b2; };
__host__ __device__ __forceinline__ LayerP layer_params(const float* const* in, int L) {
    LayerP p;
    if (L == 0) { p.w_in = in[5]; p.fbias = nullptr; p.w_o = in[6]; p.g1 = in[7]; p.b1 = in[8]; p.router = in[9]; p.rbias = in[10]; p.wgu = in[11]; p.wd = in[12]; p.sgu = in[13]; p.sd = in[14]; p.g2 = in[15]; p.b2 = in[16]; }
    else { p.w_in = in[17]; p.fbias = in[18]; p.w_o = in[19]; p.g1 = in[20]; p.b1 = in[21]; p.router = in[22]; p.rbias = in[23]; p.wgu = in[24]; p.wd = in[25]; p.sgu = in[26]; p.sd = in[27]; p.g2 = in[28]; p.b2 = in[29]; }
    return p;
}
constexpr int NPH = 15;
#ifndef PROBE_REP
#define PROBE_REP 0
#endif
#ifndef FAST_MASK
#define FAST_MASK 63
#endif
constexpr int F_PRO = 1, F_INPROJ = 2, F_ATTN = 4, F_OUTPROJ = 8, F_GU = 16, F_DOWN = 32;
constexpr int FAST = FAST_MASK;

__global__ void __launch_bounds__(NWAVES * 64, 2) mega(Args a) {
    extern __shared__ __attribute__((aligned(16))) unsigned char shm[];
    LAS unsigned char* lds = (LAS unsigned char*)shm;
    const int tid = threadIdx.x;
    unsigned char* ws = a.ws;
    volatile LAS unsigned* MISC = (volatile LAS unsigned*)(lds + MISC_OFF);
    if (tid < 64) ((LAS unsigned*)(lds + MISC_OFF))[tid] = 0u;
    __syncthreads();
    const int lo = a.ph_lo, hi = a.ph_hi;
    const bool multi = (hi - lo) > 1;
    XcdBarrier bar; bar.bar = (unsigned*)(ws + WS_CTL) + CW_BAR; bar.x = 0; bar.st = nullptr;
    if (multi) bar = xcd_barrier_post((unsigned*)(ws + WS_CTL) + CW_BAR, MISC + 8);
#define IN(k) (lo <= (k) && (k) < hi)
#define SEAM(k) do { if (IN(k) && IN((k) + 1)) xcd_barrier(bar); } while (0)
    const int G = (int)gridDim.x, bx = (int)blockIdx.x;
    const int vcu = (G % 8 == 0) ? (bx % 8) * (G / 8) + bx / 8 : bx;
    for (int rp_ = 0; rp_ <= ((a.rep >> 0) & 1); ++rp_) if constexpr ((FAST & (F_PRO | F_INPROJ | F_OUTPROJ | F_GU | F_DOWN)) != 0) { if (IN(0)) phase_prologue(lds, a); }
    SEAM(0);
    for (int L = 0; L < 2; ++L) {
        const LayerP P = layer_params(a.in, L);
        const int pb = 1 + 7 * L;
        for (int rp_ = 0; rp_ <= ((a.rep >> 1) & 1); ++rp_) if constexpr ((FAST & F_INPROJ) != 0) { if (IN(pb + 0)) {
            pg8::PlainOrder S; S.init((const bf16_t*)(ws + WS_XB), (const bf16_t*)(ws + (L == 0 ? WS_WIN0 : WS_WIN1)), S_, L == 0 ? NQKV0 : NQKV1P, D_, G, bx);
            pg8::EpiHead E{(bf16_t*)(ws + WS_QKV), S_, 40, 1, L == 0 ? nullptr : (float*)(ws + WS_FLOG)};
            pg8::gemm_phase(lds, S, E);
            if (L == 0) { pg8::PlainOrder S2; S2.init((const bf16_t*)(ws + WS_MEMN), (const bf16_t*)(ws + WS_WMEM), NMEM, 1024, D_, G, G - 1 - bx);
                pg8::EpiHead E2{(bf16_t*)(ws + WS_KVMEM), NMEM, 8, 0, nullptr}; pg8::gemm_phase(lds, S2, E2); }
        } }
        SEAM(pb + 0);
        for (int rp_ = 0; rp_ <= ((a.rep >> 2) & 1); ++rp_) if constexpr ((FAST & F_ATTN) != 0) { if (IN(pb + 1)) { const LayerPW PW{P.wgu, P.sgu, P.wd, P.sd}; phase_attention(shm, ws, L, P.fbias, PW, !(((a.rep >> 8) & 1) && rp_ > 0)); } }
        SEAM(pb + 1);
        for (int rp_ = 0; rp_ <= ((a.rep >> 3) & 1); ++rp_) if constexpr ((FAST & F_OUTPROJ) != 0) { if (IN(pb + 2)) {
            pg8::PlainOrder S; S.init((const bf16_t*)(ws + WS_AO), (const bf16_t*)(ws + (L == 0 ? WS_WO0 : WS_WO1)), S_, D_, D_, G, bx);
            pg8::EpiT1 E{L == 0 ? a.in[0] : (const float*)(ws + WS_X2F), (float*)(ws + WS_T1)};
            pg8::gemm_phase(lds, S, E);
        } }
        SEAM(pb + 2);
        if (IN(pb + 3)) { phase_ln_router(lds, ws, P.g1, P.b1, P.router, P.rbias, L); }
        SEAM(pb + 3);
        for (int rp_ = 0; rp_ <= ((a.rep >> 5) & 1); ++rp_) if constexpr ((FAST & F_GU) != 0) { if (IN(pb + 4)) {
            build_prefix(lds, (const unsigned*)(ws + WS_CTL) + CW_CNT + 64 * L);
            pg8::GroupedOrder<true> S{(const bf16_t*)(ws + WS_X1B), (const bf16_t*)(ws + (L == 0 ? WS_WGU0 : WS_WGU1)), D_, 1024, 4, G, vcu,
                (const LAS int*)(lds + LDSCTL_OFF + 512), (const LAS int*)(lds + LDSCTL_OFF), (const int*)(ws + WS_LIST), (const LAS unsigned char*)(lds + TEXP_OFF)};
            pg8::EpiGU E{(bf16_t*)(ws + WS_H)};
            pg8::gemm_phase(lds, S, E);
        } }
        SEAM(pb + 4);
        for (int rp_ = 0; rp_ <= ((a.rep >> 6) & 1); ++rp_) if constexpr ((FAST & F_DOWN) != 0) { if (IN(pb + 5)) {
            build_prefix(lds, (const unsigned*)(ws + WS_CTL) + CW_CNT + 64 * L);
            pg8::GroupedOrder<false> S{(const bf16_t*)(ws + WS_H), (const bf16_t*)(ws + (L == 0 ? WS_WD0 : WS_WD1)), EFF, D_, 8, G, vcu,
                (const LAS int*)(lds + LDSCTL_OFF + 512), (const LAS int*)(lds + LDSCTL_OFF), (const int*)(ws + WS_LIST), (const LAS unsigned char*)(lds + TEXP_OFF)};
            pg8::EpiDown E{(bf16_t*)(ws + WS_Y), (const float*)(ws + WS_ROWW)};
            pg8::gemm_phase(lds, S, E);
        } }
        SEAM(pb + 5);
        for (int rp_ = 0; rp_ <= ((a.rep >> 7) & 1); ++rp_) if (IN(pb + 6)) { phase_combine(lds, ws, P.g2, P.b2, L == 0 ? (float*)(ws + WS_X2F) : a.out, L == 0 ? (bf16_t*)(ws + WS_XB) : nullptr, L); }
        SEAM(pb + 6);
    }
#undef IN
#undef SEAM
}

extern "C" void kernel_launch(void* const* d_in, const int* in_sizes, int n_in, void* d_out, int out_size, void* d_ws, size_t ws_size, hipStream_t stream) {
    static int grid = 0;
    if (grid == 0) {
        if (n_in != 30 || out_size != S_ * D_ || ws_size < WS_END) { fprintf(stderr, "kernel_launch: unexpected shapes n_in %d out %d ws %zu\n", n_in, out_size, ws_size); grid = -1; return; }
        if (hipFuncSetAttribute((const void*)mega, hipFuncAttributeMaxDynamicSharedMemorySize, LDS_BYTES) != hipSuccess) { fprintf(stderr, "hipFuncSetAttribute failed\n"); grid = -1; return; }
        int dev = 0, cus = 0, per_cu = 0; (void)hipGetDevice(&dev); (void)hipDeviceGetAttribute(&cus, hipDeviceAttributeMultiprocessorCount, dev);
        (void)hipOccupancyMaxActiveBlocksPerMultiprocessor(&per_cu, (const void*)mega, NWAVES * 64, LDS_BYTES);
        (void)hipGetLastError();
        grid = (cus > 0 && per_cu >= 1) ? cus : 256; if (grid > 256) grid = 256;
    }
    if (grid < 0) return;
    unsigned char* ws = (unsigned char*)d_ws;
    (void)hipMemsetAsync(ws + WS_CTL, 0, CTL_ZERO_BYTES, stream);
    Args a{};
    for (int i = 0; i < 30; ++i) a.in[i] = (const float*)d_in[i];
    a.out = (float*)d_out; a.ws = ws; a.rep = PROBE_REP;
    auto run_mega = [&](int lo, int hi) { a.ph_lo = lo; a.ph_hi = hi; hipLaunchKernelGGL(mega, dim3(grid), dim3(NWAVES * 64), LDS_BYTES, stream, a); };
    if (FAST == 63) { run_mega(0, NPH); return; }
    const bool any_fast_gemm = (FAST & (F_INPROJ | F_OUTPROJ | F_GU | F_DOWN)) != 0;
    if ((FAST & F_PRO) || any_fast_gemm) run_mega(0, 1);
    else hipLaunchKernelGGL(slow_prep, dim3(1024), dim3(256), 0, stream, a.in[0], a.in[1], a.in[2], a.in[3], (bf16_t*)(ws + WS_XB), (bf16_t*)(ws + WS_MEMN));
    for (int L = 0; L < 2; ++L) {
        const LayerP P = layer_params(a.in, L); const int pb = 1 + 7 * L;
        const float* xf = (L == 0) ? a.in[0] : (const float*)(ws + WS_X2F);
        if (FAST & F_INPROJ) run_mega(pb + 0, pb + 1);
        else {
            SlowP p{}; p.A = (const bf16_t*)(ws + WS_XB); p.W = P.w_in; p.K = D_; p.ldw = (L == 0) ? NQKV0 : NQKV1; p.N = p.ldw; p.M = S_; p.L = L; p.ws = ws;
            hipLaunchKernelGGL(slow_gemm<0>, dim3((p.N + 63) / 64, S_ / 64), dim3(256), 0, stream, p);
            if (L == 0) { SlowP q{}; q.A = (const bf16_t*)(ws + WS_MEMN); q.W = a.in[4]; q.K = D_; q.ldw = 1024; q.N = 1024; q.M = NMEM; q.ws = ws;
                hipLaunchKernelGGL(slow_gemm<2>, dim3(16, NMEM / 64), dim3(256), 0, stream, q); }
        }
        if (FAST & F_ATTN) run_mega(pb + 1, pb + 2);
        else {
            const bf16_t* qkv = (const bf16_t*)(ws + WS_QKV); const bf16_t* kvm = (const bf16_t*)(ws + WS_KVMEM); float* cfn = (float*)(ws + WS_CFN); bf16_t* ao = (bf16_t*)(ws + WS_AO);
            if (L == 0) hipLaunchKernelGGL(slow_attn<0>, dim3(NH * S_ / 4), dim3(256), 0, stream, qkv, kvm, (const float*)cfn, ao);
            else { hipLaunchKernelGGL(slow_scan, dim3(1), dim3(64), 0, stream, (const float*)(ws + WS_FLOG), P.fbias, cfn);
                   hipLaunchKernelGGL(slow_attn<1>, dim3(NH * S_ / 4), dim3(256), 0, stream, qkv, kvm, (const float*)cfn, ao); }
            hipLaunchKernelGGL(slow_attn<2>, dim3(NMH * S_ / 4), dim3(256), 0, stream, qkv, kvm, (const float*)cfn, ao);
        }
        if (FAST & F_OUTPROJ) run_mega(pb + 2, pb + 3);
        else { SlowP p{}; p.A = (const bf16_t*)(ws + WS_AO); p.W = P.w_o; p.K = D_; p.ldw = D_; p.N = D_; p.M = S_; p.L = L; p.ws = ws; p.xf = xf;
            hipLaunchKernelGGL(slow_gemm<1>, dim3(D_ / 64, S_ / 64), dim3(256), 0, stream, p); }
        run_mega(pb + 3, pb + 4);
        if (FAST & F_GU) run_mega(pb + 4, pb + 5);
        else { SlowP p{}; p.A = (const bf16_t*)(ws + WS_X1B); p.W = P.wgu; p.W2 = P.sgu; p.K = D_; p.ldw = 2 * EFF; p.N = EFF; p.M = MAXROWS; p.L = L; p.ws = ws;
            hipLaunchKernelGGL(slow_gemm<3>, dim3(EFF / 64, MAXROWS / 64), dim3(256), 0, stream, p); }
        if (FAST & F_DOWN) run_mega(pb + 5, pb + 6);
        else { SlowP p{}; p.A = (const bf16_t*)(ws + WS_H); p.W = P.wd; p.W2 = P.sd; p.K = EFF; p.ldw = D_; p.N = D_; p.M = MAXROWS; p.L = L; p.ws = ws;
            hipLaunchKernelGGL(slow_gemm<4>, dim3(D_ / 64, MAXROWS / 64), dim3(256), 0, stream, p); }
        run_mega(pb + 6, pb + 7);
    }
}
```

```cpp
#include <hip/hip_runtime.h>
#include <cstdio>
#include <cstdint>

#define LAS __attribute__((address_space(3)))
#define GAS __attribute__((address_space(1)))
typedef unsigned short bf16_t;
typedef short bf16x8 __attribute__((ext_vector_type(8)));
typedef short s16x4 __attribute__((ext_vector_type(4)));
typedef float f32x2 __attribute__((ext_vector_type(2)));
typedef float f32x4 __attribute__((ext_vector_type(4)));
typedef float f32x16 __attribute__((ext_vector_type(16)));
typedef unsigned u32x2 __attribute__((ext_vector_type(2)));
typedef unsigned u32x4 __attribute__((ext_vector_type(4)));

constexpr int S_ = 8192, D_ = 2048, HD = 128, NH = 12, NMH = 4, NMEM = 256, NE = 64, TOPK = 8, EFF = 512;
constexpr int NQKV0 = 5120, NQKV1 = 5132, NQKV1P = 5376;
constexpr float ALPHA = 1.4142135623730951f, LN_EPS = 1e-5f, LOG2E = 1.4426950408889634f, LN2 = 0.6931471805599453f;
constexpr float QSCALE = 0.08838834764831845f * 1.4426950408889634f;
constexpr int MAXTILES = 352, MAXROWS = MAXTILES * 256, YP = D_ + 64;

constexpr size_t MiB = 1u << 20;
constexpr size_t WS_CTL = 0, CTL_ZERO_BYTES = 1 * MiB;
constexpr size_t WS_WIN0 = 1 * MiB, WS_WIN1 = 21 * MiB, WS_WO0 = 42 * MiB, WS_WO1 = 50 * MiB, WS_WMEM = 58 * MiB;
constexpr size_t WS_WGU0 = 62 * MiB, WS_WGU1 = 322 * MiB, WS_WD0 = 582 * MiB, WS_WD1 = 712 * MiB;
constexpr size_t WS_XB = 842 * MiB, WS_X2F = 874 * MiB, WS_QKV = 938 * MiB, WS_FLOG = 1018 * MiB, WS_KVMEM = 1019 * MiB, WS_MEMN = 1020 * MiB;
constexpr size_t WS_AO = 1021 * MiB, WS_T1 = 1053 * MiB, WS_X1F = 1117 * MiB, WS_X1B = 1181 * MiB;
constexpr size_t WS_TKE = 1213 * MiB, WS_TKW = WS_TKE + 256 * 1024, WS_TKP = WS_TKE + 512 * 1024, WS_LIST = 1214 * MiB, WS_ROWW = 1216 * MiB;
constexpr size_t WS_H = 1218 * MiB, WS_Y = 1306 * MiB, WS_CFN = 1670 * MiB, WS_END = 1671 * MiB;
static_assert(WS_Y + (size_t)MAXROWS * YP * 2 <= WS_CFN, "y fits");
constexpr int CW_BAR = 4096, CW_CNT = 16384;

__device__ __forceinline__ unsigned cvtpk(float lo, float hi) { unsigned r; asm volatile("v_cvt_pk_bf16_f32 %0, %1, %2" : "=v"(r) : "v"(lo), "v"(hi)); return r; }
__device__ __forceinline__ float bf2f(bf16_t b) { return __uint_as_float(((unsigned)b) << 16); }
__device__ __forceinline__ bf16_t f2bf(float f) { return (bf16_t)(cvtpk(f, 0.f) & 0xffffu); }
__device__ __forceinline__ int crow(int r, int hi) { return (r & 3) + 8 * (r >> 2) + 4 * hi; }
__device__ __forceinline__ float wave_sum(float v) {
#pragma unroll
    for (int o = 1; o < 64; o <<= 1) v += __shfl_xor(v, o);
    return v;
}
__device__ __forceinline__ float wave_max(float v) {
#pragma unroll
    for (int o = 1; o < 64; o <<= 1) v = fmaxf(v, __shfl_xor(v, o));
    return v;
}
__device__ __forceinline__ float softplusf(float z) { return fmaxf(z, 0.f) + log1pf(expf(-fabsf(z))); }

__device__ __forceinline__ int opaque_tid() { int t = (int)threadIdx.x; asm volatile("" : "+v"(t)); return t; }
struct Args { const float* in[30]; float* out; unsigned char* ws; int ph_lo, ph_hi, rep, pad; };

__device__ __forceinline__ void slow_prefix(const unsigned* gcnt, int* cntl, int* tp) {
    if (threadIdx.x < 64) cntl[threadIdx.x] = (int)gcnt[threadIdx.x];
    if (threadIdx.x == 64) cntl[64] = S_;
    __syncthreads();
    if (threadIdx.x == 0) { int a = 0; for (int e = 0; e < 65; ++e) { tp[e] = a; a += (cntl[e] + 255) >> 8; } tp[65] = a; }
    __syncthreads();
}
struct SlowP { const bf16_t* A; const float* W; int K, ldw, N, M; int L, pad; unsigned char* ws; const float* xf; const float* W2; };
template <int MODE> __global__ __launch_bounds__(256) void slow_gemm(SlowP p) {
    __shared__ int cntl[65]; __shared__ int tp[66];
    const int wave = threadIdx.x >> 6, lane = threadIdx.x & 63, r = lane & 31, hi = lane >> 5, wm = wave >> 1, wn = wave & 1;
    const int n0 = blockIdx.x * 64 + wn * 32; int m0 = blockIdx.y * 64 + wm * 32;
    const bf16_t* arow; const float* W = p.W; int e = 0, cnt = 0, lbase = 0;
    if (MODE >= 3) {
        slow_prefix((const unsigned*)(p.ws + WS_CTL) + CW_CNT + 64 * p.L, cntl, tp);
        const int tile = (blockIdx.y * 64) >> 8; if (tile >= tp[65]) return;
        while (tp[e + 1] <= tile) ++e;
        cnt = cntl[e]; lbase = (tile - tp[e]) * 256 + ((blockIdx.y * 64) & 255) + wm * 32;
        if (MODE == 3) { const int lr = lbase + r; int tok = 0; if (lr < cnt) tok = (e < 64) ? ((const int*)(p.ws + WS_LIST))[e * S_ + lr] : lr; arow = p.A + (size_t)tok * p.K;
            W = (e < 64) ? p.W + (size_t)e * D_ * 1024 : p.W2; }
        else { arow = p.A + (size_t)(m0 + r) * p.K; W = (e < 64) ? p.W + (size_t)e * EFF * D_ : p.W2; }
    } else arow = p.A + (size_t)(m0 + r) * p.K;
    const int col = n0 + r; const bool cok = col < p.N;
    f32x16 acc = {}, acc2 = {};
    for (int k0 = 0; k0 < p.K; k0 += 16) {
        const bf16x8 a = *(const bf16x8*)(arow + k0 + 8 * hi);
        float bv[8], bu[8];
#pragma unroll
        for (int j = 0; j < 8; ++j) { bv[j] = cok ? W[(size_t)(k0 + 8 * hi + j) * p.ldw + col] : 0.f; if (MODE == 3) bu[j] = W[(size_t)(k0 + 8 * hi + j) * p.ldw + col + EFF]; }
        u32x4 bw = {cvtpk(bv[0], bv[1]), cvtpk(bv[2], bv[3]), cvtpk(bv[4], bv[5]), cvtpk(bv[6], bv[7])};
        acc = __builtin_amdgcn_mfma_f32_32x32x16_bf16(a, *(bf16x8*)&bw, acc, 0, 0, 0);
        if (MODE == 3) { u32x4 bw2 = {cvtpk(bu[0], bu[1]), cvtpk(bu[2], bu[3]), cvtpk(bu[4], bu[5]), cvtpk(bu[6], bu[7])};
            acc2 = __builtin_amdgcn_mfma_f32_32x32x16_bf16(a, *(bf16x8*)&bw2, acc2, 0, 0, 0); }
    }
    if (!cok) return;
#pragma unroll
    for (int g = 0; g < 16; ++g) {
        const int row = m0 + crow(g, hi); const float v = acc[g];
        if (MODE == 0) {
            if (col < 5120) { const int head = col >> 7; const float sc = (head < 12 || head >= 36) ? QSCALE : 1.f;
                ((bf16_t*)(p.ws + WS_QKV))[((size_t)head * S_ + row) * HD + (col & 127)] = f2bf(v * sc); }
            else ((float*)(p.ws + WS_FLOG))[(size_t)(col - 5120) * S_ + row] = v;
        } else if (MODE == 1) {
            ((bf16_t*)(p.ws + WS_T1))[(size_t)row * D_ + col] = f2bf(ALPHA * bf2f(((const bf16_t*)(p.ws + WS_XB))[(size_t)row * D_ + col]) + v);
        } else if (MODE == 2) {
            ((bf16_t*)(p.ws + WS_KVMEM))[((size_t)(col >> 7) * NMEM + row) * HD + (col & 127)] = f2bf(v);
        } else if (MODE == 3) {
            const float u = acc2[g]; const float hv = v / (1.f + expf(-v)) * u;
            ((bf16_t*)(p.ws + WS_H))[(size_t)row * EFF + col] = f2bf(hv);
        } else {
            const int lr = lbase + crow(g, hi); float gate = 0.f; if (lr < cnt) gate = (e < 64) ? ((const float*)(p.ws + WS_ROWW))[e * S_ + lr] : 1.f;
            ((bf16_t*)(p.ws + WS_Y))[(size_t)row * YP + col] = f2bf(v * gate);
        }
    }
}
__global__ void slow_scan(const float* flog, const float* fbias, float* cfn) {
    const int h = threadIdx.x; if (h >= NH) return;
    float a = 0.f; const float b = fbias[h];
    for (int t = 0; t < S_; ++t) { a += -softplusf(-(flog[(size_t)h * S_ + t] + b)); cfn[(size_t)h * S_ + t] = a; }
}
template <int MODE> __global__ __launch_bounds__(256) void slow_attn(const bf16_t* qkv, const bf16_t* kvmem, const float* cfn, bf16_t* ao) {
    __shared__ float qs[4][HD];
    const int wave = threadIdx.x >> 6, lane = threadIdx.x & 63;
    const int gw = blockIdx.x * 4 + wave, head = gw / S_, t = gw % S_;
    const int qh = (MODE == 2) ? 36 + head : head;
    const bf16_t* q = qkv + ((size_t)qh * S_ + t) * HD;
    const bf16_t* K = (MODE == 2) ? kvmem + (size_t)head * NMEM * HD : qkv + (size_t)(12 + head) * S_ * HD;
    const bf16_t* V = (MODE == 2) ? kvmem + (size_t)(4 + head) * NMEM * HD : qkv + (size_t)(24 + head) * S_ * HD;
    qs[wave][lane] = bf2f(q[lane]) * LN2; qs[wave][lane + 64] = bf2f(q[lane + 64]) * LN2;
    __syncthreads();
    const int nkeys = (MODE == 0) ? t : (MODE == 1 ? t + 1 : NMEM);
    const int nch = (nkeys + 63) >> 6;
    float o0 = 0.f, o1 = 0.f, carry = 0.f, mrun = -__builtin_inff(), lrun = 0.f;
    const float cft = (MODE == 1) ? cfn[(size_t)head * S_ + t] : 0.f;
    for (int ci = 0; ci < nch; ++ci) {
        const int c = (MODE == 0) ? nch - 1 - ci : ci; const int base = c * 64, key = base + lane; const bool valid = key < nkeys;
        float z = 0.f;
        if (valid) { const bf16_t* kr = K + (size_t)key * HD;
            for (int d8 = 0; d8 < 16; ++d8) { const bf16x8 kv = *(const bf16x8*)(kr + d8 * 8);
#pragma unroll
                for (int j = 0; j < 8; ++j) z += qs[wave][d8 * 8 + j] * bf2f((bf16_t)kv[j]); } }
        float w;
        if (MODE == 0) {
            const float ls = valid ? -softplusf(z) : 0.f; float s = ls;
#pragma unroll
            for (int off = 1; off < 64; off <<= 1) { const float v = __shfl_down(s, off); if (lane + off < 64) s += v; }
            const float la = s - ls + carry; w = valid ? expf(z + ls + la) : 0.f; carry += __shfl(s, 0);
        } else {
            float lg = valid ? z : -__builtin_inff(); if (MODE == 1 && valid) lg += cft - cfn[(size_t)head * S_ + key];
            const float mc = wave_max(lg), mn = fmaxf(mrun, mc), al = expf(mrun - mn);
            w = valid ? expf(lg - mn) : 0.f; lrun = lrun * al + wave_sum(w); o0 *= al; o1 *= al; mrun = mn;
        }
        for (int j = 0; j < 64; ++j) { if (base + j >= nkeys) break; const float wj = __shfl(w, j);
            const unsigned vv = *(const unsigned*)(V + (size_t)(base + j) * HD + 2 * lane);
            o0 += wj * __uint_as_float(vv << 16); o1 += wj * __uint_as_float(vv & 0xffff0000u); }
    }
    if (MODE != 0) { const float il = 1.f / lrun; o0 *= il; o1 *= il; }
    const int ocol = ((MODE == 2) ? 12 + head : head) * HD + 2 * lane;
    *(unsigned*)(ao + (size_t)t * D_ + ocol) = cvtpk(o0, o1);
}
__global__ __launch_bounds__(256) void slow_prep(const float* x, const float* mem, const float* g, const float* b, bf16_t* xb, bf16_t* memn) {
    const size_t n = (size_t)S_ * D_;
    for (size_t i = (size_t)blockIdx.x * 256 + threadIdx.x; i < n; i += (size_t)gridDim.x * 256) xb[i] = f2bf(x[i]);
    const int wave = threadIdx.x >> 6, lane = threadIdx.x & 63, gw = blockIdx.x * 4 + wave;
    if (gw < NMEM) { const float* row = mem + (size_t)gw * D_; float s = 0.f; for (int i = lane; i < D_; i += 64) s += row[i]; const float mean = wave_sum(s) / D_;
        float q = 0.f; for (int i = lane; i < D_; i += 64) { const float d = row[i] - mean; q += d * d; } const float rstd = 1.f / sqrtf(wave_sum(q) / D_ + LN_EPS);
        for (int i = lane; i < D_; i += 64) memn[(size_t)gw * D_ + i] = f2bf((row[i] - mean) * rstd * g[i] + b[i]); }
}

constexpr int NWAVES = 8;
constexpr int RING_BYTES = 131072, LDSCTL_OFF = RING_BYTES, TEXP_OFF = LDSCTL_OFF + 1024, MISC_OFF = LDSCTL_OFF + 2560;
constexpr int LDS_BYTES = 147456;
#define RLX_AGENT __ATOMIC_RELAXED, __HIP_MEMORY_SCOPE_AGENT
#define LDS_WAIT() asm volatile("s_waitcnt lgkmcnt(0)" ::: "memory")
#define VM_WAIT() asm volatile("s_waitcnt vmcnt(0)" ::: "memory")

#define XB_TMO      128
#define XB_XCNT(j)  (256  + 64 * (j))
#define XB_XSUB(j)  (1280 + 64 * (j))
#define XB_XGEN(j)  (2304 + 64 * (j))
#define XB_TOP      3328
#define XB_TOPGEN   3392
#define XCD_BAR_WORDS 3456
#define XB_SPIN_CAP (1u << 18)
__device__ __forceinline__ unsigned xb_ld(unsigned* p)              { return __hip_atomic_load(p, __ATOMIC_RELAXED, __HIP_MEMORY_SCOPE_AGENT); }
__device__ __forceinline__ unsigned xb_add(unsigned* p, unsigned v) { return __hip_atomic_fetch_add(p, v, __ATOMIC_RELAXED, __HIP_MEMORY_SCOPE_AGENT); }
__device__ __forceinline__ unsigned xb_xcc_id() { return (unsigned)__builtin_amdgcn_s_getreg((3 << 11) | 20) & 0xFu; }
#define XB_SPIN(cond, bar) do { unsigned _sp = 0; while (cond) { __builtin_amdgcn_s_sleep(1); \
    if ((++_sp & 255u) == 0u) { if (xb_ld(&(bar)[XB_TMO])) break; if (_sp > XB_SPIN_CAP) { atomicAdd(&(bar)[XB_TMO], 1u); break; } } } } while (0)
struct XcdBarrier { unsigned* bar; unsigned x; volatile LAS unsigned* st; };
__device__ __forceinline__ XcdBarrier xcd_barrier_post(unsigned* bar, volatile LAS unsigned* st) {
    XcdBarrier b; b.bar = bar; b.x = xb_xcc_id(); b.st = st;
    if (threadIdx.x == 0) (void)xb_add(&bar[XB_XCNT(b.x)], 1u);
    return b;
}
__device__ __forceinline__ void xcd_barrier_complete(unsigned* bar, unsigned x, unsigned& nloc, unsigned& nx) {
    const unsigned G = gridDim.x * gridDim.y * gridDim.z;
    unsigned sum, cnt, mine, sp = 0u;
    for (;;) {
        sum = 0u; cnt = 0u; mine = 0u;
#pragma unroll
        for (unsigned j = 0; j < 16; ++j) { const unsigned c = xb_ld(&bar[XB_XCNT(j)]); sum += c; cnt += (c > 0u) ? 1u : 0u; mine = (j == x) ? c : mine; }
        if (sum == G) break;
        __builtin_amdgcn_s_sleep(1);
        if ((++sp & 255u) == 0u) { if (xb_ld(&bar[XB_TMO])) break; if (sp > XB_SPIN_CAP) { atomicAdd(&bar[XB_TMO], 1u); break; } }
    }
    nloc = mine > 0u ? mine : 1u; nx = cnt > 0u ? cnt : 1u;
}
__device__ __forceinline__ void xcd_barrier(const XcdBarrier& b) {
    asm volatile("s_waitcnt vmcnt(0)" ::: "memory");
    __syncthreads();
    if (threadIdx.x == 0) {
        unsigned* bar = b.bar;
        __builtin_amdgcn_s_waitcnt(0);
        unsigned nloc = b.st[0], nx = b.st[1];
        if (nloc == 0u) { xcd_barrier_complete(bar, b.x, nloc, nx); b.st[0] = nloc; b.st[1] = nx; }
        const unsigned old = xb_add(&bar[XB_XSUB(b.x)], 1u);
        const unsigned gen = old / nloc;
        if (old + 1u == (gen + 1u) * nloc) {
            __builtin_amdgcn_fence(__ATOMIC_RELEASE, "agent");
            asm volatile("s_waitcnt vmcnt(0)" ::: "memory");
            const unsigned og = xb_add(&bar[XB_TOP], 1u);
            const unsigned tg = og / nx;
            if (og + 1u == (tg + 1u) * nx) xb_add(&bar[XB_TOPGEN], 1u);
            else XB_SPIN(xb_ld(&bar[XB_TOPGEN]) == tg, bar);
            __builtin_amdgcn_fence(__ATOMIC_ACQUIRE, "agent");
            xb_add(&bar[XB_XGEN(b.x)], 1u);
            asm volatile("s_waitcnt vmcnt(0)" ::: "memory");
        } else {
            XB_SPIN(xb_ld(&bar[XB_XGEN(b.x)]) == gen, bar);
            __builtin_amdgcn_fence(__ATOMIC_ACQUIRE, "agent");
            asm volatile("s_waitcnt vmcnt(0)" ::: "memory");
        }
    }
    __syncthreads();
}

__device__ __forceinline__ void build_prefix(LAS unsigned char* lds, const unsigned* gcnt) {
    LAS int* cntl = (LAS int*)(lds + LDSCTL_OFF); LAS int* tp = (LAS int*)(lds + LDSCTL_OFF + 512);
    const int tid = opaque_tid();
    if (tid < 64) cntl[tid] = (int)__hip_atomic_load(gcnt + tid, RLX_AGENT);
    if (tid == 64) cntl[64] = S_;
    __syncthreads();
    if (tid == 0) { int a = 0; for (int e = 0; e < 65; ++e) { tp[e] = a; a += (cntl[e] + 255) >> 8; } tp[65] = a; }
    __syncthreads();
    if (tid < 65) { LAS unsigned char* texp = lds + TEXP_OFF; for (int t = tp[tid]; t < tp[tid + 1]; ++t) texp[t] = (unsigned char)tid; }
    __syncthreads();
}

__device__ __forceinline__ void phase_ln_router(LAS unsigned char* lds, unsigned char* ws, const float* g, const float* b, const float* Wr, const float* rbias, int L, bool commit) {
    const int tid = opaque_tid(), lane = tid & 63, w = __builtin_amdgcn_readfirstlane(tid >> 6), r32 = lane & 31, hi = lane >> 5;
    const bf16_t* t1 = (const bf16_t*)(ws + WS_T1); float* x1f = (float*)(ws + WS_X1F); bf16_t* x1b = (bf16_t*)(ws + WS_X1B);
    int* tke = (int*)(ws + WS_TKE); int* tkp = (int*)(ws + WS_TKP); int* list = (int*)(ws + WS_LIST); float* roww = (float*)(ws + WS_ROWW);
    unsigned* gcnt = (unsigned*)(ws + WS_CTL) + CW_CNT + 64 * L;
    LAS float* part = (LAS float*)lds; LAS float* logits = (LAS float*)(lds + 65536);
    LAS int* lcnt = (LAS int*)(lds + 73728); LAS int* gbase = (LAS int*)(lds + 73728 + 256);
    LAS int* ent_e = (LAS int*)(lds + 74240); LAS float* ent_w = (LAS float*)(lds + 74240 + 1024); LAS int* ent_r = (LAS int*)(lds + 74240 + 2048);
    for (int rg = blockIdx.x; rg < S_ / 32; rg += gridDim.x) {
        if (tid < 64) lcnt[tid] = 0;
#pragma unroll 1
        for (int i = 0; i < 4; ++i) {
            const size_t row = (size_t)rg * 32 + w * 4 + i;
            const u32x4* tr = (const u32x4*)(t1 + row * D_) + lane; f32x4 v[8]; float s = 0.f;
#pragma unroll
            for (int j = 0; j < 4; ++j) { const u32x4 q = tr[64 * j];
                v[2 * j] = (f32x4){__uint_as_float(q[0] << 16), __uint_as_float(q[0] & 0xffff0000u), __uint_as_float(q[1] << 16), __uint_as_float(q[1] & 0xffff0000u)};
                v[2 * j + 1] = (f32x4){__uint_as_float(q[2] << 16), __uint_as_float(q[2] & 0xffff0000u), __uint_as_float(q[3] << 16), __uint_as_float(q[3] & 0xffff0000u)}; }
#pragma unroll
            for (int j = 0; j < 8; ++j) s += (v[j][0] + v[j][1]) + (v[j][2] + v[j][3]);
            const float mean = wave_sum(s) * (1.f / D_); float q = 0.f;
#pragma unroll
            for (int j = 0; j < 8; ++j) { v[j] = v[j] - mean; q += (v[j][0] * v[j][0] + v[j][1] * v[j][1]) + (v[j][2] * v[j][2] + v[j][3] * v[j][3]); }
            const float rstd = 1.f / sqrtf(wave_sum(q) * (1.f / D_) + LN_EPS);
#pragma unroll
            for (int j = 0; j < 4; ++j) { const int c = 8 * lane + 512 * j;
                const f32x4 y0 = v[2 * j] * rstd * *(const f32x4*)(g + c) + *(const f32x4*)(b + c), y1 = v[2 * j + 1] * rstd * *(const f32x4*)(g + c + 4) + *(const f32x4*)(b + c + 4);
                *(f32x4*)(x1f + row * D_ + c) = y0; *(f32x4*)(x1f + row * D_ + c + 4) = y1;
                u32x4 pk = {cvtpk(y0[0], y0[1]), cvtpk(y0[2], y0[3]), cvtpk(y1[0], y1[1]), cvtpk(y1[2], y1[3])}; *(u32x4*)(x1b + row * D_ + c) = pk; }
        }
        VM_WAIT(); __syncthreads();
        {
            f32x16 acc0 = {}, acc1 = {};
            const float* xr = x1f + ((size_t)rg * 32 + r32) * D_ + 256 * w + 4 * hi;
            const float* wr = Wr + (size_t)(256 * w + 4 * hi) * NE + r32;
#pragma unroll 4
            for (int q = 0; q < 32; ++q) { const f32x4 a4 = *(const f32x4*)(xr + 8 * q);
#pragma unroll
                for (int j = 0; j < 4; ++j) { const float b0 = wr[(8 * q + j) * NE], b1 = wr[(8 * q + j) * NE + 32];
                    acc0 = __builtin_amdgcn_mfma_f32_32x32x2f32(a4[j], b0, acc0, 0, 0, 0); acc1 = __builtin_amdgcn_mfma_f32_32x32x2f32(a4[j], b1, acc1, 0, 0, 0); } }
            LAS float* pw = part + w * 2048;
#pragma unroll
            for (int r = 0; r < 16; ++r) { pw[crow(r, hi) * 64 + r32] = acc0[r]; pw[crow(r, hi) * 64 + 32 + r32] = acc1[r]; }
        }
        __syncthreads();
        { const int tok = tid >> 4, e4 = (tid & 15) * 4; f32x4 s = {0.f, 0.f, 0.f, 0.f};
#pragma unroll
          for (int ww = 0; ww < 8; ++ww) s += *(const LAS f32x4*)(part + ww * 2048 + tok * 64 + e4);
          *(LAS f32x4*)(logits + tok * 64 + e4) = s; }
        __syncthreads();
        const float rb = rbias[lane];
#pragma unroll 1
        for (int i = 0; i < 4; ++i) {
            const int tok = w * 4 + i; const float x = logits[tok * 64 + lane];
            const float score = 1.f / (1.f + expf(-x)), sel = score + rb; const float NEG = -__builtin_inff();
            float m1 = sel; m1 = fmaxf(m1, __shfl_xor(m1, 1)); m1 = fmaxf(m1, __shfl_xor(m1, 2)); m1 = fmaxf(m1, __shfl_xor(m1, 4));
            const unsigned long long mk = __ballot(sel == m1); const unsigned grp = (unsigned)(mk >> (8 * (lane >> 3))) & 0xffu; const int first = __ffs((int)grp) - 1;
            float m2 = ((lane & 7) == first) ? NEG : sel; m2 = fmaxf(m2, __shfl_xor(m2, 1)); m2 = fmaxf(m2, __shfl_xor(m2, 2)); m2 = fmaxf(m2, __shfl_xor(m2, 4));
            const float gs = m1 + m2; int rank = 0;
#pragma unroll
            for (int g2 = 0; g2 < 8; ++g2) { const float og = __shfl(gs, g2 * 8); rank += (og > gs || (og == gs && g2 < (lane >> 3))) ? 1 : 0; }
            float mv = (rank < 4) ? sel : NEG; bool chosen = false;
#pragma unroll 1
            for (int it = 0; it < TOPK; ++it) { const float m = wave_max(mv); const unsigned long long cm = __ballot(mv == m); const int es = __ffsll((long long)cm) - 1; if (lane == es) { chosen = true; mv = NEG; } }
            const float wsum = wave_sum(chosen ? score : 0.f); const float wgt = score / wsum * 2.5f;
            const unsigned long long cmask = __ballot(chosen); const int kpos = __popcll(cmask & ((1ull << lane) - 1ull));
            if (chosen && kpos < TOPK) { const int lr = __hip_atomic_fetch_add((int*)(lcnt + lane), 1, __ATOMIC_RELAXED, __HIP_MEMORY_SCOPE_WORKGROUP);
                ent_e[tok * 8 + kpos] = lane; ent_w[tok * 8 + kpos] = wgt; ent_r[tok * 8 + kpos] = lr; }
        }
        __syncthreads();
        if (tid < 64 && commit) gbase[tid] = (int)__hip_atomic_fetch_add(gcnt + tid, (unsigned)lcnt[tid], RLX_AGENT);
        __syncthreads();
        if (tid < 256 && commit) { const int tok = tid >> 3, k = tid & 7, e = ent_e[tid], pos = gbase[e] + ent_r[tid]; const int t = rg * 32 + tok;
            tke[t * 8 + k] = e; tkp[t * 8 + k] = pos; roww[(size_t)e * S_ + pos] = ent_w[tid]; list[(size_t)e * S_ + pos] = t; }
        __syncthreads();
    }
}

__device__ __forceinline__ void phase_combine(LAS unsigned char* lds, unsigned char* ws, const float* g, const float* b, float* xo, bf16_t* xob, int L) {
    const int tid = opaque_tid(), lane = tid & 63, w = __builtin_amdgcn_readfirstlane(tid >> 6);
    build_prefix(lds, (const unsigned*)(ws + WS_CTL) + CW_CNT + 64 * L);
    const LAS int* tp = (const LAS int*)(lds + LDSCTL_OFF + 512);
    const float* x1f = (const float*)(ws + WS_X1F); const bf16_t* y = (const bf16_t*)(ws + WS_Y);
    const int* tke = (const int*)(ws + WS_TKE); const int* tkp = (const int*)(ws + WS_TKP);
    const int ysh = tp[64] * 256;
    for (int t = blockIdx.x * NWAVES + w; t < S_; t += gridDim.x * NWAVES) {
        int me = 0, mp = 0; if (lane < TOPK) { me = tke[t * 8 + lane]; mp = tkp[t * 8 + lane]; }
        const int myrow = (lane < TOPK) ? tp[me] * 256 + mp : ysh + t;
        f32x4 v[4][2];
#pragma unroll
        for (int j = 0; j < 4; ++j) { const float* xr = x1f + (size_t)t * D_ + 8 * lane + 512 * j; v[j][0] = *(const f32x4*)xr * ALPHA; v[j][1] = *(const f32x4*)(xr + 4) * ALPHA; }
#pragma unroll 1
        for (int k = 0; k < TOPK + 1; ++k) {
            const int yr = __shfl(myrow, k); const bf16_t* yp = y + (size_t)yr * YP + 8 * lane;
#pragma unroll
            for (int j = 0; j < 4; ++j) { const u32x4 q = *(const u32x4*)(yp + 512 * j);
                v[j][0][0] += __uint_as_float(q[0] << 16); v[j][0][1] += __uint_as_float(q[0] & 0xffff0000u); v[j][0][2] += __uint_as_float(q[1] << 16); v[j][0][3] += __uint_as_float(q[1] & 0xffff0000u);
                v[j][1][0] += __uint_as_float(q[2] << 16); v[j][1][1] += __uint_as_float(q[2] & 0xffff0000u); v[j][1][2] += __uint_as_float(q[3] << 16); v[j][1][3] += __uint_as_float(q[3] & 0xffff0000u); }
        }
        float s = 0.f;
#pragma unroll
        for (int j = 0; j < 4; ++j) s += ((v[j][0][0] + v[j][0][1]) + (v[j][0][2] + v[j][0][3])) + ((v[j][1][0] + v[j][1][1]) + (v[j][1][2] + v[j][1][3]));
        const float mean = wave_sum(s) * (1.f / D_); float q2 = 0.f;
#pragma unroll
        for (int j = 0; j < 4; ++j) { v[j][0] = v[j][0] - mean; v[j][1] = v[j][1] - mean;
            q2 += ((v[j][0][0] * v[j][0][0] + v[j][0][1] * v[j][0][1]) + (v[j][0][2] * v[j][0][2] + v[j][0][3] * v[j][0][3])) + ((v[j][1][0] * v[j][1][0] + v[j][1][1] * v[j][1][1]) + (v[j][1][2] * v[j][1][2] + v[j][1][3] * v[j][1][3])); }
        const float rstd = 1.f / sqrtf(wave_sum(q2) * (1.f / D_) + LN_EPS);
#pragma unroll
        for (int j = 0; j < 4; ++j) { const int c = 8 * lane + 512 * j;
            const f32x4 y0 = v[j][0] * rstd * *(const f32x4*)(g + c) + *(const f32x4*)(b + c), y1 = v[j][1] * rstd * *(const f32x4*)(g + c + 4) + *(const f32x4*)(b + c + 4);
            if (xo) { *(f32x4*)(xo + (size_t)t * D_ + c) = y0; *(f32x4*)(xo + (size_t)t * D_ + c + 4) = y1; }
            if (xob) { u32x4 pk = {cvtpk(y0[0], y0[1]), cvtpk(y0[2], y0[3]), cvtpk(y1[0], y1[1]), cvtpk(y1[2], y1[3])}; *(u32x4*)(xob + (size_t)t * D_ + c) = pk; } }
    }
}


struct ConvTile { const float* s0; bf16_t* d0; int ldN, ldK, nvalid; };
template <bool FULL> __device__ __forceinline__ void conv_load(const ConvTile& c, f32x4 (&v)[16], int lane) {
    const int q = lane >> 4, p = lane & 15; const bool ok = FULL || (4 * p + 3 < c.nvalid);
    const float* s = c.s0 + (size_t)(16 * q) * c.ldN + 4 * p;
    if (FULL) {
#pragma unroll
        for (int i = 0; i < 16; ++i) v[i] = *(const f32x4*)(s + (size_t)i * c.ldN);
    } else {
#pragma unroll
        for (int i = 0; i < 16; ++i) v[i] = ok ? *(const f32x4*)(s + (size_t)i * c.ldN) : (f32x4){0.f, 0.f, 0.f, 0.f};
    }
}
template <bool FULL> __device__ __forceinline__ void conv_store(const ConvTile& c, const f32x4 (&v)[16], LAS unsigned char* scr, int lane) {
    const int q = lane >> 4, p = lane & 15;
#pragma unroll
    for (int cc = 0; cc < 2; ++cc)
#pragma unroll
        for (int j = 0; j < 4; ++j) { u32x4 w = {cvtpk(v[8 * cc + 0][j], v[8 * cc + 1][j]), cvtpk(v[8 * cc + 2][j], v[8 * cc + 3][j]), cvtpk(v[8 * cc + 4][j], v[8 * cc + 5][j]), cvtpk(v[8 * cc + 6][j], v[8 * cc + 7][j])};
            *(LAS u32x4*)(scr + (4 * p + j) * 144 + (16 * q + 8 * cc) * 2) = w; }
    LDS_WAIT(); asm volatile("" ::: "memory");
#pragma unroll
    for (int i = 0; i < 8; ++i) { const int n = (lane >> 3) + 8 * i; const u32x4 w = *(const LAS u32x4*)(scr + n * 144 + (lane & 7) * 16);
        if (FULL || n < c.nvalid) *(u32x4*)(c.d0 + (size_t)n * c.ldK + 8 * (lane & 7)) = w; }
    LDS_WAIT(); asm volatile("" ::: "memory");
}
struct LayerPW { const float *wgu, *sgu, *wd, *sd; };
struct ConvJob { const float* src; bf16_t* dst; int K, N, nb, gu; size_t dstride; };
__device__ __forceinline__ int conv_tiles(const ConvJob& j) { return j.nb * (j.K / 64) * ((j.N + 63) / 64); }
__device__ __forceinline__ ConvTile conv_ref(const ConvJob& j, int t) {
    const int ntn = (j.N + 63) / 64, ntk = j.K / 64, per = ntk * ntn;
    const int bi = t / per, r = t - bi * per, kt = r / ntn, nt = r - kt * ntn;
    const int n0 = nt * 64; int nvalid = j.N - n0; if (nvalid > 64) nvalid = 64;
    int drow0 = n0; if (j.gu) drow0 = 256 * ((n0 & 511) >> 7) + 128 * (n0 >> 9) + (n0 & 127);
    ConvTile c; c.s0 = j.src + (size_t)bi * j.K * j.N + (size_t)(kt * 64) * j.N + n0; c.d0 = j.dst + (size_t)bi * j.dstride + (size_t)drow0 * j.K + kt * 64; c.ldN = j.N; c.ldK = j.K; c.nvalid = nvalid; return c;
}
__device__ __forceinline__ void conv_run(const ConvJob& j, int t, LAS unsigned char* scr, int lane) { f32x4 v[16]; const ConvTile c = conv_ref(j, t); conv_load<false>(c, v, lane); conv_store<false>(c, v, scr, lane); }
__device__ __forceinline__ void conv_chunk8(const ConvJob& j, int t0, LAS unsigned char* scr, int lane) {
    f32x4 va[16], vb[16];
    ConvTile ca = conv_ref(j, t0), cb; conv_load<true>(ca, va, lane);
#pragma unroll 1
    for (int i = 0; i < 8; i += 2) {
        cb = conv_ref(j, t0 + i + 1); conv_load<true>(cb, vb, lane);
        conv_store<true>(ca, va, scr, lane);
        ca = conv_ref(j, t0 + ((i + 2 < 8) ? i + 2 : i)); conv_load<true>(ca, va, lane);
        conv_store<true>(cb, vb, scr, lane);
    }
}
__device__ __forceinline__ void phase_prologue(LAS unsigned char* lds, const Args& a) {
    const int tid = opaque_tid(), lane = tid & 63, w = __builtin_amdgcn_readfirstlane(tid >> 6);
    unsigned char* ws = a.ws;
    const int gw = blockIdx.x * NWAVES + w, NGW = gridDim.x * NWAVES;
    LAS unsigned char* scr = lds + w * 9216;
    { const f32x4* x4 = (const f32x4*)a.in[0]; u32x2* o = (u32x2*)(ws + WS_XB); const size_t n4 = (size_t)S_ * D_ / 4;
      for (size_t i = (size_t)blockIdx.x * 512 + tid; i < n4; i += (size_t)gridDim.x * 512) { const f32x4 v = x4[i]; u32x2 pk = {cvtpk(v[0], v[1]), cvtpk(v[2], v[3])}; o[i] = pk; } }
    for (int m = gw; m < NMEM; m += NGW) { const f32x4* tr = (const f32x4*)(a.in[1] + (size_t)m * D_) + lane; f32x4 v[8]; float s = 0.f;
#pragma unroll
        for (int j = 0; j < 8; ++j) { v[j] = tr[64 * j]; s += (v[j][0] + v[j][1]) + (v[j][2] + v[j][3]); }
        const float mean = wave_sum(s) * (1.f / D_); float q = 0.f;
#pragma unroll
        for (int j = 0; j < 8; ++j) { v[j] = v[j] - mean; q += (v[j][0] * v[j][0] + v[j][1] * v[j][1]) + (v[j][2] * v[j][2] + v[j][3] * v[j][3]); }
        const float rstd = 1.f / sqrtf(wave_sum(q) * (1.f / D_) + LN_EPS);
#pragma unroll
        for (int j = 0; j < 8; ++j) { const f32x4 y = v[j] * rstd * ((const f32x4*)a.in[2])[lane + 64 * j] + ((const f32x4*)a.in[3])[lane + 64 * j];
            u32x2 pk = {cvtpk(y[0], y[1]), cvtpk(y[2], y[3])}; ((u32x2*)(ws + WS_MEMN + (size_t)m * D_ * 2))[lane + 64 * j] = pk; } }
    { u32x4* z = (u32x4*)(ws + WS_WIN1 + (size_t)NQKV1 * D_ * 2); const size_t n = (size_t)(NQKV1P - NQKV1) * D_ * 2 / 16;
      for (size_t i = (size_t)blockIdx.x * 512 + tid; i < n; i += (size_t)gridDim.x * 512) z[i] = (u32x4){0u, 0u, 0u, 0u}; }
    ConvJob jobs[5];
    jobs[0] = ConvJob{a.in[5], (bf16_t*)(ws + WS_WIN0), D_, NQKV0, 1, 0, 0};
    jobs[1] = ConvJob{a.in[4], (bf16_t*)(ws + WS_WMEM), D_, 1024, 1, 0, 0};
    jobs[2] = ConvJob{a.in[6], (bf16_t*)(ws + WS_WO0), D_, D_, 1, 0, 0};
    jobs[3] = ConvJob{a.in[17], (bf16_t*)(ws + WS_WIN1), D_, NQKV1, 1, 0, 0};
    jobs[4] = ConvJob{a.in[19], (bf16_t*)(ws + WS_WO1), D_, D_, 1, 0, 0};
#pragma unroll
    for (int ji = 0; ji < 5; ++ji) { const int nt = conv_tiles(jobs[ji]);
        for (int t = gw; t < nt; t += NGW) conv_run(jobs[ji], t, scr, lane); }
}
constexpr int CW_QUEUE = 20480;
__device__ __forceinline__ void conv_moe(LAS unsigned char* lds, unsigned char* ws, const LayerPW& P, int L) {
    const int tid = opaque_tid(), lane = tid & 63, w = __builtin_amdgcn_readfirstlane(tid >> 6);
    LAS unsigned char* scr = lds + w * 9216;
    bf16_t* gu = (bf16_t*)(ws + (L == 0 ? WS_WGU0 : WS_WGU1)); bf16_t* dn = (bf16_t*)(ws + (L == 0 ? WS_WD0 : WS_WD1));
    const ConvJob j0{P.wgu, gu, D_, 1024, 64, 1, (size_t)1024 * D_}, j1{P.sgu, gu + (size_t)64 * 1024 * D_, D_, 1024, 1, 1, 0},
                  j2{P.wd, dn, EFF, D_, 64, 0, (size_t)D_ * EFF}, j3{P.sd, dn + (size_t)64 * D_ * EFF, EFF, D_, 1, 0, 0};
    constexpr int C0 = 64 * 32 * 16 / 8, C1 = C0 + 32 * 16 / 8, C2 = C1 + 64 * 8 * 32 / 8, C3 = C2 + 8 * 32 / 8;
    unsigned* qw = (unsigned*)(ws + WS_CTL) + CW_QUEUE + 64 * L;
    for (;;) {
        unsigned c = 0; if (lane == 0) c = __hip_atomic_fetch_add(qw, 1u, RLX_AGENT);
        const int ch = __builtin_amdgcn_readfirstlane((int)c);
        if (ch >= C3) break;
        if (ch < C0) conv_chunk8(j0, ch * 8, scr, lane); else if (ch < C1) conv_chunk8(j1, (ch - C0) * 8, scr, lane);
        else if (ch < C2) conv_chunk8(j2, (ch - C1) * 8, scr, lane); else conv_chunk8(j3, (ch - C2) * 8, scr, lane);
    }
}

namespace pg8 {
constexpr int BM = 256, BK = 64, HALF = 128, HTB = HALF * BK * 2, STAGE_BYTES = 8 * HTB, NXCD = 8, WGM = 8;
__host__ __device__ __forceinline__ int lds_byte(int r, int c) { const int st = (r >> 4) * 2 + (c >> 5), rr = r & 15, cc = c & 31, ob = rr * 64 + cc * 2; return st * 1024 + (ob ^ (((ob >> 9) & 1) << 5)); }
__host__ __device__ __forceinline__ void stage_rc(int b, int& R, int& C) { const int st = b / 1024, sb = b % 1024, swz = sb ^ (((sb >> 9) & 1) << 5); R = (st >> 1) * 16 + swz / 64; C = (st & 1) * 32 + (swz % 64) / 2; }
__host__ __device__ __forceinline__ int perm32(int rho) { const int n = rho >> 4, i = rho & 15; return 8 * (i >> 2) + 4 * n + (i & 3); }
struct Unit { int pm, pn, e, cnt, orow; };
struct PlainOrder {
    static constexpr bool GATHER = false;
    const bf16_t* A; const bf16_t* Bt; int K; int nM, nN, nwg, G, c;
    __device__ void init(const bf16_t* A_, const bf16_t* Bt_, int M, int N, int K_, int G_, int c_) { A = A_; Bt = Bt_; K = K_; nM = M / BM; nN = N / BM; nwg = nM * nN; G = G_; c = c_; }
    __device__ bool next(int i, Unit& u) const {
        const long L = (long)i * G + c; if (c < 0 || L >= nwg) return false;
        int wgid = (int)L; { const int q = nwg / NXCD, r = nwg % NXCD, xcd = wgid % NXCD, off = wgid / NXCD; wgid = (xcd < r ? xcd * (q + 1) : r * (q + 1) + (xcd - r) * q) + off; }
        const int nig = WGM * nN, gid = wgid / nig, fm = gid * WGM, gsz = (nM - fm) < WGM ? (nM - fm) : WGM;
        u.pm = fm + ((wgid % nig) % gsz); u.pn = (wgid % nig) / gsz; u.e = 0; u.cnt = 0; u.orow = u.pm * BM; return true;
    }
    __device__ __forceinline__ int total() const { return nwg; }
    __device__ __forceinline__ const char* a_base(const Unit& u) const { return (const char*)A + (size_t)u.pm * BM * K * 2; }
    __device__ __forceinline__ const char* b_base(const Unit& u) const { return (const char*)Bt + (size_t)u.pn * BM * K * 2; }
    __device__ __forceinline__ void gather_offs(const Unit&, int, int, int, int, unsigned (&)[4]) const {}
};
template <bool GATHER_> struct GroupedOrder {
    static constexpr bool GATHER = GATHER_;
    const bf16_t* A; const bf16_t* Bt; int K, Nexp  , npn, G, c; const LAS int* tp; const LAS int* cntl; const int* list; const LAS unsigned char* texp;
    __device__ bool next(int i, Unit& u) const {
        const int L = i * G + c, total = tp[65] * npn; if (L >= total) return false;
        const int tile = L / npn; u.pn = L - tile * npn; const int e = (int)texp[tile];
        u.e = e; u.pm = tile - tp[e]; u.cnt = cntl[e]; u.orow = tile * BM; return true;
    }
    __device__ __forceinline__ int total() const { return tp[65] * npn; }
    __device__ __forceinline__ const char* a_base(const Unit& u) const { return GATHER ? (const char*)A : (const char*)A + (size_t)u.orow * K * 2; }
    __device__ __forceinline__ const char* b_base(const Unit& u) const { return (const char*)Bt + ((size_t)u.e * Nexp + (size_t)u.pn * BM) * K * 2; }
    __device__ __forceinline__ void gather_offs(const Unit& u, int R0, int C0, int R1, int C1, unsigned (&vo)[4]) const {
#pragma unroll
        for (int h = 0; h < 2; ++h) { const int l0 = u.pm * BM + h * HALF + R0, l1 = u.pm * BM + h * HALF + R1; int t0 = 0, t1 = 0;
            if (u.e < 64) { if (l0 < u.cnt) t0 = list[(size_t)u.e * S_ + l0]; if (l1 < u.cnt) t1 = list[(size_t)u.e * S_ + l1]; } else { t0 = l0; t1 = l1; }
            vo[2 * h] = (unsigned)(t0 * K + C0) * 2u; vo[2 * h + 1] = (unsigned)(t1 * K + C1) * 2u; }
    }
};

template <class Epi, class Sched>
__device__ __forceinline__ void gemm_phase(LAS unsigned char* lds, const Sched& S, const Epi& E, int stagger_ticks = 0) {
    constexpr bool GA = Sched::GATHER;
    if (stagger_ticks > 0) { const int tot = S.total(), G_ = S.G, c_ = S.c, rem = tot % G_;
        if (rem != 0 && c_ >= rem && c_ >= 0) { const long long dl = (long long)stagger_ticks * (c_ - rem) / (G_ - rem); const unsigned long long t0 = __builtin_amdgcn_s_memrealtime();
            while ((long long)(__builtin_amdgcn_s_memrealtime() - t0) < dl) __builtin_amdgcn_s_sleep(16); } }
    const int tid = opaque_tid(), wid = __builtin_amdgcn_readfirstlane(tid >> 6), lane = tid & 63, wr = wid >> 2, wc = wid & 3, fr = lane & 15, fq = lane >> 4;
    const int K = S.K, nt = K / BK;
    unsigned voffA[2], voffB[2]; int Rs[2], Cs[2];
#pragma unroll
    for (int i = 0; i < 2; ++i) { int R, C; stage_rc(tid * 16 + i * 8192, R, C); Rs[i] = R; Cs[i] = C; const int Rb = Epi::PERM ? ((R & ~31) + perm32(R & 31)) : R;
        voffA[i] = (unsigned)(R * K + C) * 2u; voffB[i] = (unsigned)(Rb * K + C) * 2u; }
    const size_t kstep = (size_t)(BK * 2);
    const size_t hstep = (size_t)HALF * K * 2;
    const unsigned ldsw = (unsigned)wid * 1024u;
    const int aoff = lds_byte(wr * 64 + fr, fq * 8), boff = lds_byte(wc * 32 + fr, fq * 8);
#define PG8_SA(b, h) (((b) * 2 + (h)) * HTB)
#define PG8_SB(b, h) ((4 + (b) * 2 + (h)) * HTB)
#define PG8_GLDS(bufoff, gptr, off, i_) __builtin_amdgcn_global_load_lds((const unsigned*)((const char*)(gptr) + (off)), (LAS unsigned*)(lds + (bufoff) + ldsw + (i_) * 8192), 16, 0, 0)
#define PG8_STAGE_B(bufoff, gbase) do { PG8_GLDS(bufoff, gbase, voffB[0], 0); PG8_GLDS(bufoff, gbase, voffB[1], 1); } while (0)
#define PG8_STAGE_A(bufoff, kptr, h, nx) do { if constexpr (GA) { PG8_GLDS(bufoff, kptr, (nx) ? vgn[2 * (h)] : vgc[2 * (h)], 0); PG8_GLDS(bufoff, kptr, (nx) ? vgn[2 * (h) + 1] : vgc[2 * (h) + 1], 1); } \
        else { PG8_GLDS(bufoff, (kptr) + (h) * hstep, voffA[0], 0); PG8_GLDS(bufoff, (kptr) + (h) * hstep, voffA[1], 1); } } while (0)
#define PG8_LDA(dst, b, h) do { _Pragma("unroll") for (int m = 0; m < 4; ++m) _Pragma("unroll") for (int k = 0; k < 2; ++k) dst[m][k] = *(const LAS bf16x8*)(lds + PG8_SA(b, h) + aoff + m * 2048 + k * 1024); } while (0)
#define PG8_LDB(dst, b, h) do { _Pragma("unroll") for (int n = 0; n < 2; ++n) _Pragma("unroll") for (int k = 0; k < 2; ++k) dst[n][k] = *(const LAS bf16x8*)(lds + PG8_SB(b, h) + boff + n * 2048 + k * 1024); } while (0)
#define PG8_MMA(ai, bj, At, Bt) do { __builtin_amdgcn_s_setprio(1); _Pragma("unroll") for (int m = 0; m < 4; ++m) _Pragma("unroll") for (int n = 0; n < 2; ++n) _Pragma("unroll") for (int k = 0; k < 2; ++k) \
        acc[ai][bj][m][n] = __builtin_amdgcn_mfma_f32_16x16x32_bf16(Bt[n][k], At[m][k], acc[ai][bj][m][n], 0, 0, 0); __builtin_amdgcn_s_setprio(0); } while (0)
#define PG8_WAIT_V(n) asm volatile("s_waitcnt vmcnt(" #n ")" ::: "memory")
#define PG8_WAIT_L(n) asm volatile("s_waitcnt lgkmcnt(" #n ")" ::: "memory")
#define PG8_BAR __builtin_amdgcn_s_barrier()
#define PG8_SCHED __builtin_amdgcn_sched_barrier(0)
    Unit cur, nxt; int ui = 0;
    if (!S.next(0, cur)) return;
    f32x4 acc[2][2][4][2];
#pragma unroll
    for (int a = 0; a < 2; ++a)
#pragma unroll
        for (int b = 0; b < 2; ++b)
#pragma unroll
            for (int m = 0; m < 4; ++m)
#pragma unroll
                for (int n = 0; n < 2; ++n) acc[a][b][m][n] = (f32x4){0.f, 0.f, 0.f, 0.f};
    bf16x8 At[4][2], B0[2][2], B1[2][2];
    unsigned vgc[4] = {0u, 0u, 0u, 0u}, vgn[4] = {0u, 0u, 0u, 0u};
    if constexpr (GA) S.gather_offs(cur, Rs[0], Cs[0], Rs[1], Cs[1], vgc);
    const char* cA = S.a_base(cur); const char* cB = S.b_base(cur);
    PG8_STAGE_B(PG8_SB(0, 0), cB); PG8_STAGE_B(PG8_SB(0, 1), cB + hstep); PG8_STAGE_A(PG8_SA(0, 0), cA, 0, false); PG8_STAGE_A(PG8_SA(0, 1), cA, 1, false);
    if (wr == 1) PG8_BAR;
    PG8_WAIT_V(2); PG8_BAR;
    PG8_STAGE_B(PG8_SB(1, 0), cB + kstep); PG8_STAGE_A(PG8_SA(1, 0), cA + kstep, 0, false); PG8_STAGE_B(PG8_SB(1, 1), cB + hstep + kstep);
    PG8_WAIT_V(6); PG8_BAR;
    for (;;) {
        const bool has_next = S.next(ui + 1, nxt);
        if constexpr (GA) { if (has_next) S.gather_offs(nxt, Rs[0], Cs[0], Rs[1], Cs[1], vgn); }
        const char* nA = has_next ? S.a_base(nxt) : cA; const char* nB = has_next ? S.b_base(nxt) : cB;
        for (int t = 0; t < nt; t += 2) {
            const bool last = (t == nt - 2);
            const bool nx = last && has_next;
            const char* a1 = cA + (size_t)(t + 1) * kstep;
            const char* a2 = last ? nA : cA + (size_t)(t + 2) * kstep; const char* b2 = last ? nB : cB + (size_t)(t + 2) * kstep;
            const char* a3 = a2 + kstep; const char* b3 = b2 + kstep;
            PG8_LDB(B0, 0, 0); PG8_LDB(B1, 0, 1); PG8_SCHED; PG8_LDA(At, 0, 0); PG8_STAGE_A(PG8_SA(1, 1), a1, 1, false);
            PG8_WAIT_V(8); PG8_WAIT_L(0); PG8_BAR; PG8_MMA(0, 0, At, B0); PG8_MMA(0, 1, At, B1); PG8_BAR; PG8_SCHED;
            PG8_LDA(At, 0, 1); PG8_STAGE_B(PG8_SB(0, 0), b2); PG8_STAGE_B(PG8_SB(0, 1), b2 + hstep); PG8_STAGE_A(PG8_SA(0, 0), a2, 0, nx);
            PG8_WAIT_V(8); PG8_WAIT_L(0); PG8_BAR; PG8_MMA(1, 0, At, B0); PG8_MMA(1, 1, At, B1); PG8_BAR; PG8_SCHED;
            PG8_LDB(B0, 1, 0); PG8_LDB(B1, 1, 1); PG8_SCHED; PG8_LDA(At, 1, 0); PG8_STAGE_A(PG8_SA(0, 1), a2, 1, nx);
            PG8_WAIT_V(8); PG8_WAIT_L(0); PG8_BAR; PG8_MMA(0, 0, At, B0); PG8_MMA(0, 1, At, B1); PG8_BAR; PG8_SCHED;
            PG8_LDA(At, 1, 1); PG8_STAGE_B(PG8_SB(1, 0), b3); PG8_STAGE_B(PG8_SB(1, 1), b3 + hstep); PG8_STAGE_A(PG8_SA(1, 0), a3, 0, nx);
            PG8_WAIT_V(8); PG8_WAIT_L(0); PG8_BAR; PG8_MMA(1, 0, At, B0); PG8_MMA(1, 1, At, B1); PG8_BAR; PG8_SCHED;
        }
        if (wr == 0) PG8_BAR;
        E(acc, cur, wr, wc, fr, fq);
        if (!has_next) break;
#pragma unroll
        for (int a = 0; a < 2; ++a)
#pragma unroll
            for (int b = 0; b < 2; ++b)
#pragma unroll
                for (int m = 0; m < 4; ++m)
#pragma unroll
                    for (int n = 0; n < 2; ++n) acc[a][b][m][n] = (f32x4){0.f, 0.f, 0.f, 0.f};
        cur = nxt; cA = nA; cB = nB; ++ui;
        if constexpr (GA) {
#pragma unroll
            for (int i = 0; i < 4; ++i) vgc[i] = vgn[i]; }
        if (wr == 1) PG8_BAR;
    }
    PG8_WAIT_V(0);
    PG8_BAR;
#undef PG8_SA
#undef PG8_SB
#undef PG8_GLDS
#undef PG8_STAGE_A
#undef PG8_STAGE_B
#undef PG8_LDA
#undef PG8_LDB
#undef PG8_MMA
#undef PG8_WAIT_V
#undef PG8_WAIT_L
#undef PG8_BAR
#undef PG8_SCHED
}

struct EpiHead {
    static constexpr bool PERM = true;
    bf16_t* dst; int rows; int nheads; int qscale; float* flog;
    __device__ __forceinline__ void operator()(const f32x4 (&acc)[2][2][4][2], const Unit& u, int wr, int wc, int fr, int fq) const {
#pragma unroll
        for (int bj = 0; bj < 2; ++bj) { const int head = 2 * u.pn + bj;
            if (head < nheads) { const float sc = (qscale && (head < 12 || head >= 36)) ? QSCALE : 1.f;
                bf16_t* base = dst + (size_t)head * rows * HD + wc * 32 + 8 * fq;
#pragma unroll
                for (int ai = 0; ai < 2; ++ai)
#pragma unroll
                    for (int m = 0; m < 4; ++m) { const int row = u.orow + ai * HALF + wr * 64 + m * 16 + fr; const f32x4 v0 = acc[ai][bj][m][0] * sc, v1 = acc[ai][bj][m][1] * sc;
                        u32x4 w = {cvtpk(v0[0], v0[1]), cvtpk(v0[2], v0[3]), cvtpk(v1[0], v1[1]), cvtpk(v1[2], v1[3])}; *(u32x4*)(base + (size_t)row * HD) = w; } }
            else if (flog && head == nheads && wc == 0 && fq < 2) {
#pragma unroll
                for (int ai = 0; ai < 2; ++ai)
#pragma unroll
                    for (int m = 0; m < 4; ++m) { const int row = u.orow + ai * HALF + wr * 64 + m * 16 + fr;
#pragma unroll
                        for (int n = 0; n < 2; ++n)
#pragma unroll
                            for (int j = 0; j < 4; ++j) { const int c = 8 * fq + 4 * n + j; if (c < NH) flog[(size_t)c * S_ + row] = acc[ai][bj][m][n][j]; } } }
        }
    }
};
struct EpiT1 {
    static constexpr bool PERM = true;
    const bf16_t* x; bf16_t* t1;
    __device__ __forceinline__ void operator()(const f32x4 (&acc)[2][2][4][2], const Unit& u, int wr, int wc, int fr, int fq) const {
        const int col0 = u.pn * BM + wc * 32 + 8 * fq;
#pragma unroll
        for (int ai = 0; ai < 2; ++ai)
#pragma unroll
            for (int m = 0; m < 4; ++m) { const size_t off = (size_t)(u.orow + ai * HALF + wr * 64 + m * 16 + fr) * D_ + col0;
#pragma unroll
                for (int bj = 0; bj < 2; ++bj) { const u32x4 xs = *(const u32x4*)(x + off + bj * HALF); const f32x4 a0 = acc[ai][bj][m][0], a1 = acc[ai][bj][m][1];
                    u32x4 w = {cvtpk(__uint_as_float(xs[0] << 16) * ALPHA + a0[0], __uint_as_float(xs[0] & 0xffff0000u) * ALPHA + a0[1]), cvtpk(__uint_as_float(xs[1] << 16) * ALPHA + a0[2], __uint_as_float(xs[1] & 0xffff0000u) * ALPHA + a0[3]),
                               cvtpk(__uint_as_float(xs[2] << 16) * ALPHA + a1[0], __uint_as_float(xs[2] & 0xffff0000u) * ALPHA + a1[1]), cvtpk(__uint_as_float(xs[3] << 16) * ALPHA + a1[2], __uint_as_float(xs[3] & 0xffff0000u) * ALPHA + a1[3])};
                    *(u32x4*)(t1 + off + bj * HALF) = w; }
                if (m & 1) asm volatile("" ::: "memory"); }
    }
};
struct EpiGU {
    static constexpr bool PERM = true;
    bf16_t* h;
    __device__ __forceinline__ void operator()(const f32x4 (&acc)[2][2][4][2], const Unit& u, int wr, int wc, int fr, int fq) const {
        bf16_t* base = h + u.pn * HALF + wc * 32 + 8 * fq;
#pragma unroll
        for (int ai = 0; ai < 2; ++ai)
#pragma unroll
            for (int m = 0; m < 4; ++m) { const int row = u.orow + ai * HALF + wr * 64 + m * 16 + fr; float o[8];
#pragma unroll
                for (int n = 0; n < 2; ++n)
#pragma unroll
                    for (int j = 0; j < 4; ++j) { const float g = acc[ai][0][m][n][j], up = acc[ai][1][m][n][j];
                        o[4 * n + j] = g * __builtin_amdgcn_rcpf(1.f + __builtin_amdgcn_exp2f(-g * LOG2E)) * up; }
                u32x4 w = {cvtpk(o[0], o[1]), cvtpk(o[2], o[3]), cvtpk(o[4], o[5]), cvtpk(o[6], o[7])}; *(u32x4*)(base + (size_t)row * EFF) = w; }
    }
};
struct EpiDown {
    static constexpr bool PERM = true;
    bf16_t* y; const float* roww;
    __device__ __forceinline__ void operator()(const f32x4 (&acc)[2][2][4][2], const Unit& u, int wr, int wc, int fr, int fq) const {
        bf16_t* base = y + u.pn * BM + wc * 32 + 8 * fq;
#pragma unroll
        for (int ai = 0; ai < 2; ++ai)
#pragma unroll
            for (int m = 0; m < 4; ++m) { const int lr = u.pm * BM + ai * HALF + wr * 64 + m * 16 + fr; const int row = u.orow + ai * HALF + wr * 64 + m * 16 + fr;
                float gt = 0.f; if (lr < u.cnt) gt = (u.e < 64) ? roww[(size_t)u.e * S_ + lr] : 1.f;
#pragma unroll
                for (int bj = 0; bj < 2; ++bj) { const f32x4 v0 = acc[ai][bj][m][0] * gt, v1 = acc[ai][bj][m][1] * gt;
                    u32x4 w = {cvtpk(v0[0], v0[1]), cvtpk(v0[2], v0[3]), cvtpk(v1[0], v1[1]), cvtpk(v1[2], v1[3])}; *(u32x4*)(base + (size_t)row * YP + bj * HALF) = w; } }
    }
};
}


namespace at {
constexpr int NW = 8, QBLK = 32, KVBLK = 64, QB = NW * QBLK, SHM_V = KVBLK * HD * 2, SHM_K = KVBLK * HD * 2;
constexpr int WS_OFF = 2 * SHM_V + 2 * SHM_K, TAB_OFF = WS_OFF + NW * 64 * 4, ZERO_OFF = TAB_OFF + S_ * 4, ATT_END = ZERO_OFF + 1024;
constexpr float THR = 8.f;
static_assert(ATT_END <= RING_BYTES, "attention LDS");
#define KSWZ(row, colB) ((row) * 256 + ((colB) ^ (((row) & 7) << 4)))
#define SBAR() __builtin_amdgcn_sched_barrier(0)
__device__ __forceinline__ int v_st(int k, int c) { const int kk = (k & ~0xC) | ((k & 4) << 1) | ((k & 8) >> 1); return ((kk >> 3) * 4 + (c >> 5)) * 512 + ((kk & 7) * 32 + (c & 31)) * 2; }
__device__ __forceinline__ int v_rd_base(int lane) { return ((lane & 3) << 3) | (((lane >> 2) & 3) << 6) | (((lane >> 4) & 1) << 5) | (((lane >> 5) & 1) << 8); }
constexpr int v_rd_off(int d0, int ks, int half) { return d0 * 512 + ks * 4096 + half * 2048; }
__device__ __forceinline__ bf16x8 load8(const bf16_t* p) { return *reinterpret_cast<const bf16x8*>(p); }
__device__ __forceinline__ void mask_tile(f32x16& p0, f32x16& p1, int dq, unsigned W) {
    const float NEG = -__builtin_inff();
#pragma unroll
    for (int r = 0; r < 16; ++r) { const int c = (r & 3) + 8 * (r >> 2);
        if ((unsigned)(dq - c) >= W) p0[r] = NEG;
        if ((unsigned)(dq - c - 32) >= W) p1[r] = NEG; }
}
#define PK4(P, B_, OUT) do { unsigned a0 = cvtpk(P[B_+0], P[B_+1]), a1 = cvtpk(P[B_+2], P[B_+3]);                          \
        unsigned b0 = cvtpk(P[B_+4], P[B_+5]), b1 = cvtpk(P[B_+6], P[B_+7]);                                             \
        auto r0 = __builtin_amdgcn_permlane32_swap(a0, b0, false, false); auto r1 = __builtin_amdgcn_permlane32_swap(a1, b1, false, false); \
        u32x4 w = {r0[0], r1[0], r0[1], r1[1]}; OUT = *reinterpret_cast<bf16x8*>(&w); } while (0)
__device__ __forceinline__ void partialSM(f32x16& p0, f32x16& p1, float& m_reg, float& mn, float& alpha) {
    float pmax = p0[0];
#pragma unroll
    for (int r = 1; r < 16; ++r) pmax = fmaxf(pmax, p0[r]);
#pragma unroll
    for (int r = 0; r < 16; ++r) pmax = fmaxf(pmax, p1[r]);
    { auto rr = __builtin_amdgcn_permlane32_swap(__float_as_uint(pmax), __float_as_uint(pmax), false, false);
      pmax = fmaxf(__uint_as_float(rr[0]), __uint_as_float(rr[1])); }
    if (__builtin_expect(__all((pmax - m_reg) <= THR), 1)) { mn = m_reg; alpha = 1.f; }
    else { mn = fmaxf(m_reg, pmax); alpha = __builtin_amdgcn_exp2f(m_reg - mn); m_reg = mn; }
#pragma unroll
    for (int r = 0; r < 16; ++r) p0[r] = p0[r] - mn;
#pragma unroll
    for (int r = 0; r < 16; ++r) p1[r] = p1[r] - mn;
#pragma unroll
    for (int r = 0; r < 16; ++r) p0[r] = __builtin_amdgcn_exp2f(p0[r]);
}
__device__ __forceinline__ void finishSM(f32x16& p0, f32x16& p1, float alpha, float& l_reg, bf16x8& pa0, bf16x8& pa1, bf16x8& pa2, bf16x8& pa3) {
#pragma unroll
    for (int r = 0; r < 16; ++r) p1[r] = __builtin_amdgcn_exp2f(p1[r]);
    float ps = 0;
#pragma unroll
    for (int r = 0; r < 16; ++r) ps += p0[r];
#pragma unroll
    for (int r = 0; r < 16; ++r) ps += p1[r];
    { auto rr = __builtin_amdgcn_permlane32_swap(__float_as_uint(ps), __float_as_uint(ps), false, false);
      ps = __uint_as_float(rr[0]) + __uint_as_float(rr[1]); }
    l_reg = l_reg * alpha + ps;
    PK4(p0, 0, pa0); PK4(p0, 8, pa1); PK4(p1, 0, pa2); PK4(p1, 8, pa3);
}
__device__ __forceinline__ void partialSB(f32x16& p0, f32x16& p1, float (&E)[8], float& tot, int hi) {
#pragma unroll
    for (int r = 0; r < 16; ++r) p0[r] = __builtin_amdgcn_rcpf(1.f + __builtin_amdgcn_exp2f(p0[r]));
#pragma unroll
    for (int r = 0; r < 16; ++r) p1[r] = __builtin_amdgcn_rcpf(1.f + __builtin_amdgcn_exp2f(p1[r]));
    float Glo[8], Ghi[8];
#pragma unroll
    for (int m = 0; m < 8; ++m) { const int b = 4 * (m & 3); const float G = (m < 4) ? (p0[b] * p0[b + 1]) * (p0[b + 2] * p0[b + 3]) : (p1[b] * p1[b + 1]) * (p1[b + 2] * p1[b + 3]);
        auto rr = __builtin_amdgcn_permlane32_swap(__float_as_uint(G), __float_as_uint(G), false, false); Glo[m] = __uint_as_float(rr[0]); Ghi[m] = __uint_as_float(rr[1]); }
    float st = 1.f;
#pragma unroll
    for (int m = 7; m >= 0; --m) { const float e1 = st * Ghi[m]; E[m] = hi ? st : e1; st = e1 * Glo[m]; }
    tot = st;
}
__device__ __forceinline__ void finishSB(f32x16& p0, f32x16& p1, const float (&E)[8], float tot, float& R, bf16x8& pa0, bf16x8& pa1, bf16x8& pa2, bf16x8& pa3) {
#pragma unroll
    for (int m = 0; m < 8; ++m) { const int b = 4 * (m & 3); float a = E[m] * R;
        if (m < 4) { const float w3 = fmaf(-a, p0[b + 3], a); a *= p0[b + 3]; const float w2 = fmaf(-a, p0[b + 2], a); a *= p0[b + 2]; const float w1 = fmaf(-a, p0[b + 1], a); a *= p0[b + 1]; const float w0 = fmaf(-a, p0[b], a);
            p0[b] = w0; p0[b + 1] = w1; p0[b + 2] = w2; p0[b + 3] = w3; }
        else { const float w3 = fmaf(-a, p1[b + 3], a); a *= p1[b + 3]; const float w2 = fmaf(-a, p1[b + 2], a); a *= p1[b + 2]; const float w1 = fmaf(-a, p1[b + 1], a); a *= p1[b + 1]; const float w0 = fmaf(-a, p1[b], a);
            p1[b] = w0; p1[b + 1] = w1; p1[b + 2] = w2; p1[b + 3] = w3; } }
    R *= tot;
    PK4(p0, 0, pa0); PK4(p0, 8, pa1); PK4(p1, 0, pa2); PK4(p1, 8, pa3);
}
#undef PK4
template <int KB, int MODE>
__device__ __forceinline__ void qkt(f32x16& p0, f32x16& p1, const char* K_lds, int r32, int hi, const bf16x8* qr, const float* tabk) {
    if (MODE == 1) {
#pragma unroll
        for (int m = 0; m < 4; ++m) { const f32x4 a = *(const f32x4*)(tabk + 8 * m), b = *(const f32x4*)(tabk + 32 + 8 * m);
#pragma unroll
            for (int j = 0; j < 4; ++j) { p0[4 * m + j] = a[j]; p1[4 * m + j] = b[j]; } }
    } else { p0 = f32x16{}; p1 = f32x16{}; }
    const char* kb[4];
#pragma unroll
    for (int dd = 0; dd < 4; ++dd) kb[dd] = K_lds + KB * SHM_K + KSWZ(r32, (dd * 16 + hi * 8) * 2);
#pragma unroll
    for (int d0 = 0; d0 < 8; ++d0) { const char* a = kb[d0 & 3] + (d0 >> 2) * 128;
        bf16x8 b0 = *reinterpret_cast<const bf16x8*>(a);
        bf16x8 b1 = *reinterpret_cast<const bf16x8*>(a + 32 * 256);
        p0 = __builtin_amdgcn_mfma_f32_32x32x16_bf16(b0, qr[d0], p0, 0, 0, 0);
        p1 = __builtin_amdgcn_mfma_f32_32x32x16_bf16(b1, qr[d0], p1, 0, 0, 0); }
}
template <int VB>
__device__ __forceinline__ void pv_tile(f32x16* o, int vb0, bf16x8 pa0, bf16x8 pa1, bf16x8 pa2, bf16x8 pa3) {
#define TRRD(dst, off) asm volatile("ds_read_b64_tr_b16 %0, %1 offset:%2" : "=&v"(dst) : "v"(vb0), "i"(off) : "memory")
#define PV_D0(d0) do { s16x4 l0, l1, l2, l3, h0, h1, h2, h3; constexpr int b_ = VB * SHM_V + v_rd_off(d0, 0, 0); \
        TRRD(l0, b_); TRRD(h0, b_ + 2048); TRRD(l1, b_ + 4096); TRRD(h1, b_ + 6144); TRRD(l2, b_ + 8192); TRRD(h2, b_ + 10240); TRRD(l3, b_ + 12288); TRRD(h3, b_ + 14336); \
        asm volatile("s_waitcnt lgkmcnt(0)" ::: "memory"); SBAR();   \
        o[d0] = __builtin_amdgcn_mfma_f32_32x32x16_bf16(pa0, (bf16x8){l0[0], l0[1], l0[2], l0[3], h0[0], h0[1], h0[2], h0[3]}, o[d0], 0, 0, 0);   \
        o[d0] = __builtin_amdgcn_mfma_f32_32x32x16_bf16(pa1, (bf16x8){l1[0], l1[1], l1[2], l1[3], h1[0], h1[1], h1[2], h1[3]}, o[d0], 0, 0, 0);   \
        o[d0] = __builtin_amdgcn_mfma_f32_32x32x16_bf16(pa2, (bf16x8){l2[0], l2[1], l2[2], l2[3], h2[0], h2[1], h2[2], h2[3]}, o[d0], 0, 0, 0);   \
        o[d0] = __builtin_amdgcn_mfma_f32_32x32x16_bf16(pa3, (bf16x8){l3[0], l3[1], l3[2], l3[3], h3[0], h3[1], h3[2], h3[3]}, o[d0], 0, 0, 0); } while (0)
    PV_D0(0); PV_D0(1); PV_D0(2); PV_D0(3);
#undef PV_D0
#undef TRRD
}
struct BlockRef { const bf16_t* Q; const bf16_t* K; const bf16_t* V; bf16_t* O; int P0, skv, tab; };
struct Seam { bf16x8 qr[8]; bf16x8 st_v0, st_v1, st_k0, st_k1; };
__device__ __forceinline__ int blk_jhi(const BlockRef& b) { int j = (b.P0 + QB - 1) / KVBLK + 1; const int mx = b.skv / KVBLK; return j > mx ? mx : j; }
template <int MODE> __device__ __forceinline__ int first_kb(const BlockRef& b) { return MODE == 0 ? (blk_jhi(b) - 1) * KVBLK : 0; }
#define ROW(p, k0, rr) ((p) + (size_t)((k0) + (rr)) * HD + sc)
#define VMW() asm volatile("s_waitcnt vmcnt(0)" ::: "memory")
#define VMWN(n) asm volatile("s_waitcnt vmcnt(%0)" :: "i"(n) : "memory")
#define SLOAD_H(Kp, Vp, k0) do { S.st_v0 = load8(ROW(Vp, k0, sr)); S.st_v1 = load8(ROW(Vp, k0, 32 + sr)); S.st_k0 = load8(ROW(Kp, k0, sr)); S.st_k1 = load8(ROW(Kp, k0, 32 + sr)); } while (0)
#define SWRITE_HK(bf) do { *(bf16x8*)(K_lds + (bf) * SHM_K + kws) = S.st_k0; *(bf16x8*)(K_lds + (bf) * SHM_K + kws + 32 * 256) = S.st_k1; } while (0)
#define SWRITE_HV(bf) do { *(bf16x8*)(V_lds + (bf) * SHM_V + vst0) = S.st_v0; *(bf16x8*)(V_lds + (bf) * SHM_V + vst1) = S.st_v1; } while (0)
#define SWRITE_H(bf) do { SWRITE_HV(bf); SWRITE_HK(bf); } while (0)
template <int MODE>
__device__ __forceinline__ void attn_prime(const BlockRef& cur, char* lds, Seam& S) {
    const int tid = opaque_tid(), wid = __builtin_amdgcn_readfirstlane(tid >> 6), lane = tid & 63, r32 = lane & 31, hi = lane >> 5;
    const int sr = tid >> 4, sc = (tid & 15) * 8, kws = KSWZ(sr, sc * 2); char* K_lds = lds + 2 * SHM_V;
    const int kb0 = first_kb<MODE>(cur);
#pragma unroll
    for (int d0 = 0; d0 < 8; ++d0) S.qr[d0] = load8(cur.Q + (size_t)(wid * QBLK + r32) * HD + d0 * 16 + hi * 8);
    SLOAD_H(cur.K, cur.V, kb0); VMW(); SWRITE_HK(0);
    __syncthreads();
}
template <int MODE>
__device__ __forceinline__ void attn_block(const BlockRef& cur, const BlockRef& nxt, char* lds, Seam& S) {
    const int tid = opaque_tid(), wid = __builtin_amdgcn_readfirstlane(tid >> 6), lane = tid & 63, r32 = lane & 31, hi = lane >> 5;
    const int j_hi = blk_jhi(cur), NT = j_hi;
    const int kbn = first_kb<MODE>(nxt);
    const int qlo = cur.P0 + wid * QBLK, qm = qlo + r32 - 4 * hi;
    char* V_lds = lds; char* K_lds = lds + 2 * SHM_V;
    float* wsf = (float*)(lds + WS_OFF) + wid * 64; float* li_l = wsf, * al_l = wsf + 32;
    const float* tabp = (const float*)(lds + cur.tab) + 4 * hi;
    float m_reg = -1e30f, l_reg = 0.f, Rrun = 1.f, tot = 1.f; float E[8]; f32x16 o[4] = {};
    const int sr = tid >> 4, sc = (tid & 15) * 8, vst0 = v_st(sr, sc), vst1 = v_st(32 + sr, sc), kws = KSWZ(sr, sc * 2);
    const int vb0 = (int)(uintptr_t)V_lds + v_rd_base(lane);
    const bf16_t* Kh = cur.K; const bf16_t* Vh = cur.V;
#define RESC(a) do { if (MODE == 1) { if (__any((a) < 1.f)) { if (hi == 0) al_l[r32] = (a); asm volatile("s_waitcnt lgkmcnt(0)" ::: "memory");              \
                     for (int d_ = 0; d_ < 4; ++d_) for (int r = 0; r < 16; ++r) o[d_][r] *= al_l[crow(r, hi)]; } } } while (0)
#define KBASE(t) ((MODE == 0 ? (j_hi - 1 - (t)) : (t)) * KVBLK)
#define MASKT(P0_, P1_, t) do { const int kb_ = KBASE(t); if (MODE == 0) { if (kb_ + KVBLK - 1 >= qlo) mask_tile(P0_, P1_, qm - kb_ - 1, 0x7fffffffu); } \
                                else { if (kb_ + KVBLK - 1 > qlo) mask_tile(P0_, P1_, qm - kb_, 0x7fffffffu); } } while (0)
#define PARTIAL(PX0, PX1, mnX, alX) do { if (MODE == 0) partialSB(PX0, PX1, E, tot, hi); else partialSM(PX0, PX1, m_reg, mnX, alX); } while (0)
#define FINISH(PY0, PY1, alY) do { if (MODE == 0) finishSB(PY0, PY1, E, tot, Rrun, pa0, pa1, pa2, pa3); else finishSM(PY0, PY1, alY, l_reg, pa0, pa1, pa2, pa3); } while (0)
    constexpr int NQL = 8;
#define SEAM_K0() do { VMWN(NQL); SWRITE_HK(0); SBAR(); } while (0)
    f32x16 pA0, pA1, pB0, pB1; float mnA = 0.f, mnB = 0.f, alA = 1.f, alB = 1.f; bf16x8 pa0, pa1, pa2, pa3;
    SWRITE_HV(0); SBAR();
    if (NT > 1) SLOAD_H(Kh, Vh, KBASE(1));
    SBAR(); qkt<0, MODE>(pA0, pA1, K_lds, r32, hi, S.qr, tabp + KBASE(0));
    MASKT(pA0, pA1, 0); PARTIAL(pA0, pA1, mnA, alA);
    if (NT > 1) { VMW(); SWRITE_H(1); }
    __syncthreads();
#define HALF_STEP(PX0, PX1, mnX, alX, PY0, PY1, alY, t, KB, VB, SB) do {                                                      \
        SBAR(); qkt<KB, MODE>(PX0, PX1, K_lds, r32, hi, S.qr, tabp + KBASE(t));                                              \
        FINISH(PY0, PY1, alY); SBAR();                                                                                        \
        if ((t) + 1 < NT) { SLOAD_H(Kh, Vh, KBASE((t) + 1)); SBAR(); }                                                        \
        pv_tile<VB>(o, vb0, pa0, pa1, pa2, pa3); MASKT(PX0, PX1, (t)); PARTIAL(PX0, PX1, mnX, alX);                           \
        __syncthreads();                                                                                                      \
        if ((t) + 1 < NT) { VMW(); SWRITE_H(SB); }                                                                            \
        RESC(alX); __syncthreads(); } while (0)
    for (int t = 1; t + 1 < NT; t += 2) {
        HALF_STEP(pB0, pB1, mnB, alB, pA0, pA1, alA, t, 1, 0, 0);
        HALF_STEP(pA0, pA1, mnA, alA, pB0, pB1, alB, t + 1, 0, 1, 1);
    }
    const bool even = (NT & 1) == 0;
    if (even) { SBAR(); qkt<1, MODE>(pB0, pB1, K_lds, r32, hi, S.qr, tabp + KBASE(NT - 1)); SBAR(); }
    SLOAD_H(nxt.K, nxt.V, kbn); SBAR();
#pragma unroll
    for (int d0 = 0; d0 < 8; ++d0) S.qr[d0] = load8(nxt.Q + (size_t)(wid * QBLK + r32) * HD + d0 * 16 + hi * 8);
    SBAR();
    FINISH(pA0, pA1, alA); SBAR();
    pv_tile<0>(o, vb0, pa0, pa1, pa2, pa3);
    if (even) { MASKT(pB0, pB1, NT - 1); PARTIAL(pB0, pB1, mnB, alB); __syncthreads(); RESC(alB);
        FINISH(pB0, pB1, alB); SBAR(); pv_tile<1>(o, vb0, pa0, pa1, pa2, pa3); }
    SBAR(); SEAM_K0();
    float rli[16];
    if (MODE == 1) { if (hi == 0) li_l[r32] = l_reg; asm volatile("s_waitcnt lgkmcnt(0)" ::: "memory");
#pragma unroll
        for (int r = 0; r < 16; ++r) rli[r] = __builtin_amdgcn_rcpf(li_l[crow(r, hi)]); }
    bf16_t* Ow = cur.O + (size_t)(wid * QBLK) * D_;
#pragma unroll
    for (int r = 0; r < 16; ++r) { const int orow = crow(r, hi);
#pragma unroll
        for (int d0 = 0; d0 < 4; ++d0) { const float v = (MODE == 1) ? o[d0][r] * rli[r] : o[d0][r];
            const float vn = __shfl_xor(v, 1);
            if ((r32 & 1) == 0) *(unsigned*)(Ow + (size_t)orow * D_ + d0 * 32 + r32) = cvtpk(v, vn); } }
    __syncthreads();
#undef RESC
#undef KBASE
#undef MASKT
#undef PARTIAL
#undef FINISH
#undef SEAM_K0
#undef HALF_STEP
}
#undef ROW
#undef VMW
#undef VMWN
#undef SLOAD_H
#undef SWRITE_HK
#undef SWRITE_HV
#undef SWRITE_H
__device__ __forceinline__ void fox_table(char* lds, const float* flogh, float bias) {
    const int tid = opaque_tid(), lane = tid & 63, wid = tid >> 6;
    float* tab = (float*)(lds + TAB_OFF); float* wt = (float*)(lds + WS_OFF);
    float p[16]; const f32x4* src = (const f32x4*)(flogh + 16 * tid);
#pragma unroll
    for (int i = 0; i < 4; ++i) { const f32x4 v = src[i];
#pragma unroll
        for (int j = 0; j < 4; ++j) p[4 * i + j] = softplusf(-(v[j] + bias)) * LOG2E; }
#pragma unroll
    for (int i = 1; i < 16; ++i) p[i] += p[i - 1];
    float inc = p[15];
#pragma unroll
    for (int off = 1; off < 64; off <<= 1) { const float v = __shfl_up(inc, off); if (lane >= off) inc += v; }
    if (lane == 63) wt[wid] = inc;
    __syncthreads();
    float base = inc - p[15];
    for (int w2 = 0; w2 < wid; ++w2) base += wt[w2];
#pragma unroll
    for (int i = 0; i < 16; ++i) tab[16 * tid + i] = base + p[i];
    __syncthreads();
}
}

__device__ __forceinline__ void phase_attention(unsigned char* shm, unsigned char* ws, int L, const float* fbias, const LayerPW& PW, bool do_conv) {
    char* lds = (char*)shm;
    const int tid0 = opaque_tid();
    { float* z = (float*)(lds + at::ZERO_OFF); if (tid0 < 256) z[tid0] = 0.f; }
    __syncthreads();
    const bf16_t* qkv = (const bf16_t*)(ws + WS_QKV); const bf16_t* kvm = (const bf16_t*)(ws + WS_KVMEM); bf16_t* ao = (bf16_t*)(ws + WS_AO);
    for (int v = blockIdx.x; v < 256; v += gridDim.x) {
        const bool mix = v < 192;
        const int head = mix ? (v >> 4) : ((v - 192) >> 4);
        const int q0 = mix ? (v & 15) : (((v - 192) * 2) & 31), q1 = mix ? 31 - q0 : q0 + 1;
        const bf16_t* Qh = qkv + (size_t)(mix ? head : 36 + head) * S_ * HD;
        const bf16_t* Kh = mix ? qkv + (size_t)(12 + head) * S_ * HD : kvm + (size_t)head * NMEM * HD;
        const bf16_t* Vh = mix ? qkv + (size_t)(24 + head) * S_ * HD : kvm + (size_t)(4 + head) * NMEM * HD;
        bf16_t* Oh = ao + (mix ? head : 12 + head) * HD;
        const int skv = mix ? S_ : NMEM, tab = mix ? at::TAB_OFF : at::ZERO_OFF;
#define MKREF(qb) at::BlockRef{Qh + (size_t)(qb) * 256 * HD, Kh, Vh, Oh + (size_t)(qb) * 256 * D_, mix ? (qb) * 256 : NMEM, skv, tab}
        at::Seam S;
        if (L == 0 && mix) {
            at::attn_prime<0>(MKREF(q0), lds, S);
#pragma unroll 1
            for (int i = 0; i < 2; ++i) at::attn_block<0>(MKREF(i ? q1 : q0), MKREF(q1), lds, S);
        } else {
            if (mix) at::fox_table(lds, (const float*)(ws + WS_FLOG) + (size_t)head * S_, fbias[head]);
            at::attn_prime<1>(MKREF(q0), lds, S);
#pragma unroll 1
            for (int i = 0; i < 2; ++i) at::attn_block<1>(MKREF(i ? q1 : q0), MKREF(q1), lds, S);
        }
#undef MKREF
    }
    if (do_conv) conv_moe((LAS unsigned char*)shm, ws, PW, L);
}

struct LayerP { const float *w_in, *fbias, *w_o, *g1, *b1, *router, *rbias, *wgu, *wd, *sgu, *sd, *g2, *b2; };
__host__ __device__ __forceinline__ LayerP layer_params(const float* const* in, int L) {
    LayerP p;
    if (L == 0) { p.w_in = in[5]; p.fbias = nullptr; p.w_o = in[6]; p.g1 = in[7]; p.b1 = in[8]; p.router = in[9]; p.rbias = in[10]; p.wgu = in[11]; p.wd = in[12]; p.sgu = in[13]; p.sd = in[14]; p.g2 = in[15]; p.b2 = in[16]; }
    else { p.w_in = in[17]; p.fbias = in[18]; p.w_o = in[19]; p.g1 = in[20]; p.b1 = in[21]; p.router = in[22]; p.rbias = in[23]; p.wgu = in[24]; p.wd = in[25]; p.sgu = in[26]; p.sd = in[27]; p.g2 = in[28]; p.b2 = in[29]; }
    return p;
}
constexpr int NPH = 15;
constexpr int STAG_IN = 0, STAG_GU = 0, STAG_DN = 0;
#ifndef PROBE_REP
#define PROBE_REP 0
#endif
#ifndef FAST_MASK
#define FAST_MASK 63
#endif
constexpr int F_PRO = 1, F_INPROJ = 2, F_ATTN = 4, F_OUTPROJ = 8, F_GU = 16, F_DOWN = 32;
constexpr int FAST = FAST_MASK;

__global__ void __launch_bounds__(NWAVES * 64, 2) mega(Args a) {
    extern __shared__ __attribute__((aligned(16))) unsigned char shm[];
    LAS unsigned char* lds = (LAS unsigned char*)shm;
    const int tid = threadIdx.x;
    unsigned char* ws = a.ws;
    volatile LAS unsigned* MISC = (volatile LAS unsigned*)(lds + MISC_OFF);
    if (tid < 64) ((LAS unsigned*)(lds + MISC_OFF))[tid] = 0u;
    __syncthreads();
    const int lo = a.ph_lo, hi = a.ph_hi;
    const bool multi = (hi - lo) > 1;
    XcdBarrier bar; bar.bar = (unsigned*)(ws + WS_CTL) + CW_BAR; bar.x = 0; bar.st = nullptr;
    if (multi) bar = xcd_barrier_post((unsigned*)(ws + WS_CTL) + CW_BAR, MISC + 8);
#define IN(k) (lo <= (k) && (k) < hi)
#define SEAM(k) do { if (IN(k) && IN((k) + 1)) { xcd_barrier(bar); if ((a.rep >> 9) & 1) xcd_barrier(bar); } } while (0)
    const int G = (int)gridDim.x, bx = (int)blockIdx.x;
    const int vcu = (G % 8 == 0) ? (bx % 8) * (G / 8) + bx / 8 : bx;
    for (int rp_ = 0; rp_ <= ((a.rep >> 0) & 1); ++rp_) if constexpr ((FAST & (F_PRO | F_INPROJ | F_OUTPROJ | F_GU | F_DOWN)) != 0) { if (IN(0)) phase_prologue(lds, a); }
    SEAM(0);
    for (int L = 0; L < 2; ++L) {
        const LayerP P = layer_params(a.in, L);
        const int pb = 1 + 7 * L;
        for (int rp_ = 0; rp_ <= ((a.rep >> 1) & 1); ++rp_) if constexpr ((FAST & F_INPROJ) != 0) { if (IN(pb + 0)) {
            pg8::PlainOrder S; S.init((const bf16_t*)(ws + WS_XB), (const bf16_t*)(ws + (L == 0 ? WS_WIN0 : WS_WIN1)), S_, L == 0 ? NQKV0 : NQKV1P, D_, G, bx);
            pg8::EpiHead E{(bf16_t*)(ws + WS_QKV), S_, 40, 1, L == 0 ? nullptr : (float*)(ws + WS_FLOG)};
            pg8::gemm_phase(lds, S, E, STAG_IN);
            if (L == 0) { pg8::PlainOrder S2; S2.init((const bf16_t*)(ws + WS_MEMN), (const bf16_t*)(ws + WS_WMEM), NMEM, 1024, D_, G, G - 1 - bx);
                pg8::EpiHead E2{(bf16_t*)(ws + WS_KVMEM), NMEM, 8, 0, nullptr}; pg8::gemm_phase(lds, S2, E2); }
        } }
        SEAM(pb + 0);
        for (int rp_ = 0; rp_ <= ((a.rep >> 2) & 1); ++rp_) if constexpr ((FAST & F_ATTN) != 0) { if (IN(pb + 1)) { const LayerPW PW{P.wgu, P.sgu, P.wd, P.sd}; phase_attention(shm, ws, L, P.fbias, PW, !(((a.rep >> 8) & 1) && rp_ > 0)); } }
        SEAM(pb + 1);
        for (int rp_ = 0; rp_ <= ((a.rep >> 3) & 1); ++rp_) if constexpr ((FAST & F_OUTPROJ) != 0) { if (IN(pb + 2)) {
            pg8::PlainOrder S; S.init((const bf16_t*)(ws + WS_AO), (const bf16_t*)(ws + (L == 0 ? WS_WO0 : WS_WO1)), S_, D_, D_, G, bx);
            pg8::EpiT1 E{(const bf16_t*)(ws + WS_XB), (bf16_t*)(ws + WS_T1)};
            pg8::gemm_phase(lds, S, E);
        } }
        SEAM(pb + 2);
        for (int rp_ = 0; rp_ <= ((a.rep >> 4) & 1); ++rp_) if (IN(pb + 3)) { phase_ln_router(lds, ws, P.g1, P.b1, P.router, P.rbias, L, rp_ == 0); }
        SEAM(pb + 3);
        for (int rp_ = 0; rp_ <= ((a.rep >> 5) & 1); ++rp_) if constexpr ((FAST & F_GU) != 0) { if (IN(pb + 4)) {
            build_prefix(lds, (const unsigned*)(ws + WS_CTL) + CW_CNT + 64 * L);
            pg8::GroupedOrder<true> S{(const bf16_t*)(ws + WS_X1B), (const bf16_t*)(ws + (L == 0 ? WS_WGU0 : WS_WGU1)), D_, 1024, 4, G, vcu,
                (const LAS int*)(lds + LDSCTL_OFF + 512), (const LAS int*)(lds + LDSCTL_OFF), (const int*)(ws + WS_LIST), (const LAS unsigned char*)(lds + TEXP_OFF)};
            pg8::EpiGU E{(bf16_t*)(ws + WS_H)};
            pg8::gemm_phase(lds, S, E, STAG_GU);
        } }
        SEAM(pb + 4);
        for (int rp_ = 0; rp_ <= ((a.rep >> 6) & 1); ++rp_) if constexpr ((FAST & F_DOWN) != 0) { if (IN(pb + 5)) {
            build_prefix(lds, (const unsigned*)(ws + WS_CTL) + CW_CNT + 64 * L);
            pg8::GroupedOrder<false> S{(const bf16_t*)(ws + WS_H), (const bf16_t*)(ws + (L == 0 ? WS_WD0 : WS_WD1)), EFF, D_, 8, G, vcu,
                (const LAS int*)(lds + LDSCTL_OFF + 512), (const LAS int*)(lds + LDSCTL_OFF), (const int*)(ws + WS_LIST), (const LAS unsigned char*)(lds + TEXP_OFF)};
            pg8::EpiDown E{(bf16_t*)(ws + WS_Y), (const float*)(ws + WS_ROWW)};
            pg8::gemm_phase(lds, S, E, STAG_DN);
        } }
        SEAM(pb + 5);
        for (int rp_ = 0; rp_ <= ((a.rep >> 7) & 1); ++rp_) if (IN(pb + 6)) { phase_combine(lds, ws, P.g2, P.b2, L == 0 ? nullptr : a.out, L == 0 ? (bf16_t*)(ws + WS_XB) : nullptr, L); }
        SEAM(pb + 6);
    }
#undef IN
#undef SEAM
}

extern "C" void kernel_launch(void* const* d_in, const int* in_sizes, int n_in, void* d_out, int out_size, void* d_ws, size_t ws_size, hipStream_t stream) {
    static int grid = 0;
    if (grid == 0) {
        if (n_in != 30 || out_size != S_ * D_ || ws_size < WS_END) { fprintf(stderr, "kernel_launch: unexpected shapes n_in %d out %d ws %zu\n", n_in, out_size, ws_size); grid = -1; return; }
        if (hipFuncSetAttribute((const void*)mega, hipFuncAttributeMaxDynamicSharedMemorySize, LDS_BYTES) != hipSuccess) { fprintf(stderr, "hipFuncSetAttribute failed\n"); grid = -1; return; }
        int dev = 0, cus = 0, per_cu = 0; (void)hipGetDevice(&dev); (void)hipDeviceGetAttribute(&cus, hipDeviceAttributeMultiprocessorCount, dev);
        (void)hipOccupancyMaxActiveBlocksPerMultiprocessor(&per_cu, (const void*)mega, NWAVES * 64, LDS_BYTES);
        (void)hipGetLastError();
        grid = (cus > 0 && per_cu >= 1) ? cus : 256; if (grid > 256) grid = 256;
    }
    if (grid < 0) return;
    unsigned char* ws = (unsigned char*)d_ws;
    (void)hipMemsetAsync(ws + WS_CTL, 0, CTL_ZERO_BYTES, stream);
    Args a{};
    for (int i = 0; i < 30; ++i) a.in[i] = (const float*)d_in[i];
    a.out = (float*)d_out; a.ws = ws; a.rep = PROBE_REP;
    auto run_mega = [&](int lo, int hi) { a.ph_lo = lo; a.ph_hi = hi; hipLaunchKernelGGL(mega, dim3(grid), dim3(NWAVES * 64), LDS_BYTES, stream, a); };
    if (FAST == 63) { run_mega(0, NPH); return; }
    const bool any_fast_gemm = (FAST & (F_INPROJ | F_OUTPROJ | F_GU | F_DOWN)) != 0;
    if ((FAST & F_PRO) || any_fast_gemm) run_mega(0, 1);
    else hipLaunchKernelGGL(slow_prep, dim3(1024), dim3(256), 0, stream, a.in[0], a.in[1], a.in[2], a.in[3], (bf16_t*)(ws + WS_XB), (bf16_t*)(ws + WS_MEMN));
    for (int L = 0; L < 2; ++L) {
        const LayerP P = layer_params(a.in, L); const int pb = 1 + 7 * L;
        const float* xf = (L == 0) ? a.in[0] : (const float*)(ws + WS_X2F);
        if (FAST & F_INPROJ) run_mega(pb + 0, pb + 1);
        else {
            SlowP p{}; p.A = (const bf16_t*)(ws + WS_XB); p.W = P.w_in; p.K = D_; p.ldw = (L == 0) ? NQKV0 : NQKV1; p.N = p.ldw; p.M = S_; p.L = L; p.ws = ws;
            hipLaunchKernelGGL(slow_gemm<0>, dim3((p.N + 63) / 64, S_ / 64), dim3(256), 0, stream, p);
            if (L == 0) { SlowP q{}; q.A = (const bf16_t*)(ws + WS_MEMN); q.W = a.in[4]; q.K = D_; q.ldw = 1024; q.N = 1024; q.M = NMEM; q.ws = ws;
                hipLaunchKernelGGL(slow_gemm<2>, dim3(16, NMEM / 64), dim3(256), 0, stream, q); }
        }
        if (FAST & F_ATTN) run_mega(pb + 1, pb + 2);
        else {
            const bf16_t* qkv = (const bf16_t*)(ws + WS_QKV); const bf16_t* kvm = (const bf16_t*)(ws + WS_KVMEM); float* cfn = (float*)(ws + WS_CFN); bf16_t* ao = (bf16_t*)(ws + WS_AO);
            if (L == 0) hipLaunchKernelGGL(slow_attn<0>, dim3(NH * S_ / 4), dim3(256), 0, stream, qkv, kvm, (const float*)cfn, ao);
            else { hipLaunchKernelGGL(slow_scan, dim3(1), dim3(64), 0, stream, (const float*)(ws + WS_FLOG), P.fbias, cfn);
                   hipLaunchKernelGGL(slow_attn<1>, dim3(NH * S_ / 4), dim3(256), 0, stream, qkv, kvm, (const float*)cfn, ao); }
            hipLaunchKernelGGL(slow_attn<2>, dim3(NMH * S_ / 4), dim3(256), 0, stream, qkv, kvm, (const float*)cfn, ao);
        }
        if (FAST & F_OUTPROJ) run_mega(pb + 2, pb + 3);
        else { SlowP p{}; p.A = (const bf16_t*)(ws + WS_AO); p.W = P.w_o; p.K = D_; p.ldw = D_; p.N = D_; p.M = S_; p.L = L; p.ws = ws; p.xf = xf;
            hipLaunchKernelGGL(slow_gemm<1>, dim3(D_ / 64, S_ / 64), dim3(256), 0, stream, p); }
        run_mega(pb + 3, pb + 4);
        if (FAST & F_GU) run_mega(pb + 4, pb + 5);
        else { SlowP p{}; p.A = (const bf16_t*)(ws + WS_X1B); p.W = P.wgu; p.W2 = P.sgu; p.K = D_; p.ldw = 2 * EFF; p.N = EFF; p.M = MAXROWS; p.L = L; p.ws = ws;
            hipLaunchKernelGGL(slow_gemm<3>, dim3(EFF / 64, MAXROWS / 64), dim3(256), 0, stream, p); }
        if (FAST & F_DOWN) run_mega(pb + 5, pb + 6);
        else { SlowP p{}; p.A = (const bf16_t*)(ws + WS_H); p.W = P.wd; p.W2 = P.sd; p.K = EFF; p.ldw = D_; p.N = D_; p.M = MAXROWS; p.L = L; p.ws = ws;
            hipLaunchKernelGGL(slow_gemm<4>, dim3(D_ / 64, MAXROWS / 64), dim3(256), 0, stream, p); }
        run_mega(pb + 6, pb + 7);
    }
}
```
